# Optimizing an MI355X kernel written in HIP

```python
import math
import jax
import jax.numpy as jnp
from jax import lax
import numpy as np

D_MODEL = 1024
BATCH = 2
SEQ = 8192
DEPTH = 4

HEAD_DIM = 64
GROUP_HEADS = 4
GROUP_WIDTH = GROUP_HEADS * HEAD_DIM
N_GROUPS = 4
MIX_WIDTH = N_GROUPS * GROUP_WIDTH
Q_BLOCK = 128

FORGET_BIAS_INIT = 2.0
DIFF_QK_DIM = HEAD_DIM // 2
DIFF_SUBLN_EPS = 1e-5
MOBA_BLOCK = 256
MOBA_TOPK = 3
MLA_Q_LORA = 256
MLA_KV_LORA = 128
MLA_NOPE = 64
MLA_ROPE = 32
MLA_V = HEAD_DIM
ROPE_THETA = 10000.0
REL_BUCKETS = 32
REL_MAX_DIST = 128
N_REL_HEADS = 2 * GROUP_HEADS
D_FF = 2752
CONV_WIDTH = 3
DEEPNORM_ALPHA = (2 * DEPTH) ** 0.25
DEEPNORM_BETA = (8 * DEPTH) ** -0.25
LN_EPS = 1e-5
RMS_EPS = 1e-6

FOX_COLS = 3 * GROUP_WIDTH + GROUP_HEADS
DIFF_COLS = 3 * GROUP_WIDTH
MOBA_COLS = 3 * GROUP_WIDTH
MLA_COLS = MLA_Q_LORA + MLA_KV_LORA + MLA_ROPE
N_IN = FOX_COLS + DIFF_COLS + MOBA_COLS + MLA_COLS
IN_SPLITS = (FOX_COLS, FOX_COLS + DIFF_COLS, FOX_COLS + DIFF_COLS + MOBA_COLS)

kernel_name = 'hybrid_fox_diff_moba_mla_convffn_deepnorm'


def _layernorm(t, g, b):
    t32 = t.astype(jnp.float32)
    mu = jnp.mean(t32, axis=-1, keepdims=True)
    var = jnp.mean(jnp.square(t32 - mu), axis=-1, keepdims=True)
    return ((t32 - mu) * lax.rsqrt(var + LN_EPS) * g + b).astype(t.dtype)


def _rmsnorm(t, g, eps=RMS_EPS):
    t32 = t.astype(jnp.float32)
    return (t32 * lax.rsqrt(jnp.mean(jnp.square(t32), axis=-1, keepdims=True) + eps) * g).astype(t.dtype)


def _heads(t, n):
    b, s, w = t.shape
    return t.reshape(b, s, n, w // n).transpose(0, 2, 1, 3)


def _merge(t):
    b, h, s, d = t.shape
    return t.transpose(0, 2, 1, 3).reshape(b, s, h * d)


def _rel_bucket(dist):
    max_exact = REL_BUCKETS // 2
    d_large = jnp.maximum(dist, max_exact).astype(jnp.float32)
    large = max_exact + (jnp.log(d_large / max_exact) / math.log(REL_MAX_DIST / max_exact)
                         * (REL_BUCKETS - max_exact)).astype(jnp.int32)
    large = jnp.minimum(large, REL_BUCKETS - 1)
    return jnp.where(dist < max_exact, dist, large)


def _rope_tables(s):
    inv = ROPE_THETA ** (-jnp.arange(0, MLA_ROPE // 2, dtype=jnp.float32) * 2.0 / MLA_ROPE)
    ang = jnp.arange(s, dtype=jnp.float32)[:, None] * inv[None, :]
    return jnp.cos(ang), jnp.sin(ang)


def _rope(t, cos, sin):
    t1, t2 = jnp.split(t, 2, axis=-1)
    cos = cos.astype(t.dtype)
    sin = sin.astype(t.dtype)
    return jnp.concatenate([t1 * cos - t2 * sin, t2 * cos + t1 * sin], axis=-1)


def _sweep_query_blocks(fn, *q_like):
    n = q_like[0].shape[2] // Q_BLOCK

    def split(t):
        t = t.reshape(t.shape[:2] + (n, Q_BLOCK) + t.shape[3:])
        return jnp.moveaxis(t, 2, 0)

    starts = jnp.arange(n, dtype=jnp.int32) * Q_BLOCK
    out = lax.map(lambda a: fn(a[0], *a[1:]), (starts,) + tuple(split(t) for t in q_like))
    out = jnp.moveaxis(out, 0, 2)
    return out.reshape(out.shape[:2] + (n * Q_BLOCK,) + out.shape[4:])


def fox_attention(q, k, v, log_f):
    s_len = k.shape[2]
    cum = jnp.cumsum(log_f, axis=-1)
    k_pos = jnp.arange(s_len)
    scale = q.shape[-1] ** -0.5

    def block(start, qb, cb):
        q_pos = start + jnp.arange(Q_BLOCK)
        s = jnp.einsum('bhqd,bhkd->bhqk', qb, k).astype(jnp.float32) * scale
        s = s + (cb[..., :, None] - cum[..., None, :])
        s = jnp.where(k_pos[None, :] <= q_pos[:, None], s, -jnp.inf)
        p = jax.nn.softmax(s, axis=-1).astype(v.dtype)
        return jnp.einsum('bhqk,bhkd->bhqd', p, v)

    return _sweep_query_blocks(block, q, cum)


def diff_attention(q, k, v, lam, bias_by_dist):
    s_len = k.shape[2]
    k_pos = jnp.arange(s_len)
    scale = q.shape[-1] ** -0.5

    def block(start, qb):
        q_pos = start + jnp.arange(Q_BLOCK)
        dist = q_pos[:, None] - k_pos[None, :]
        bias = bias_by_dist[:, jnp.clip(dist, 0, s_len - 1)]
        s = jnp.einsum('bhqnd,bhknd->bhnqk', qb, k).astype(jnp.float32) * scale + bias[None, :, None]
        s = jnp.where(dist >= 0, s, -jnp.inf)
        p = jax.nn.softmax(s, axis=-1)
        a = p[:, :, 0] - lam * p[:, :, 1]
        return jnp.einsum('bhqk,bhkd->bhqd', a.astype(v.dtype), v)

    return _sweep_query_blocks(block, q)


def moba_attention(q, k, v, bias_by_dist):
    b, h, s_len, dh = k.shape
    nb = max(-(-s_len // MOBA_BLOCK), MOBA_TOPK)
    pad = nb * MOBA_BLOCK - s_len
    kp = jnp.pad(k, ((0, 0), (0, 0), (0, pad), (0, 0)))
    vp = jnp.pad(v, ((0, 0), (0, 0), (0, pad), (0, 0)))
    kb = kp.reshape(b, h, nb, MOBA_BLOCK, dh)
    vb = vp.reshape(b, h, nb, MOBA_BLOCK, dh)
    k_mean = jnp.mean(kb.astype(jnp.float32), axis=3).astype(k.dtype)
    blk = jnp.arange(nb)
    within = jnp.arange(MOBA_BLOCK)
    b_ix = jnp.arange(b)[:, None, None, None]
    h_ix = jnp.arange(h)[None, :, None, None]
    scale = dh ** -0.5
    n_sel = MOBA_TOPK * MOBA_BLOCK

    def block(start, qb):
        q_pos = start + jnp.arange(Q_BLOCK)
        own = start // MOBA_BLOCK
        gate = jnp.einsum('bhqd,bhnd->bhqn', qb, k_mean).astype(jnp.float32)
        gate = jnp.where(blk < own, gate, -jnp.inf)
        _, sel = lax.top_k(gate, MOBA_TOPK)
        valid = jnp.arange(MOBA_TOPK) < own
        k_sel = kb[b_ix, h_ix, sel]
        v_sel = vb[b_ix, h_ix, sel]
        sel_dist = q_pos[:, None, None] - (sel[..., None] * MOBA_BLOCK + within)
        sel_bias = bias_by_dist[h_ix[..., None], jnp.clip(sel_dist, 0, s_len - 1)]
        s_sel = jnp.einsum('bhqd,bhqnkd->bhqnk', qb, k_sel).astype(jnp.float32) * scale + sel_bias
        s_sel = jnp.where(valid[:, None], s_sel, -jnp.inf).reshape(b, h, Q_BLOCK, n_sel)
        own_start = own * MOBA_BLOCK
        k_own = lax.dynamic_slice_in_dim(kp, own_start, MOBA_BLOCK, axis=2)
        v_own = lax.dynamic_slice_in_dim(vp, own_start, MOBA_BLOCK, axis=2)
        own_dist = q_pos[:, None] - (own_start + within)[None, :]
        own_bias = bias_by_dist[:, jnp.clip(own_dist, 0, s_len - 1)]
        s_own = jnp.einsum('bhqd,bhkd->bhqk', qb, k_own).astype(jnp.float32) * scale + own_bias[None]
        s_own = jnp.where(own_dist >= 0, s_own, -jnp.inf)
        p = jax.nn.softmax(jnp.concatenate([s_sel, s_own], axis=-1), axis=-1).astype(v.dtype)
        p_sel = p[..., :n_sel].reshape(b, h, Q_BLOCK, MOBA_TOPK, MOBA_BLOCK)
        return (jnp.einsum('bhqnk,bhqnkd->bhqd', p_sel, v_sel)
                + jnp.einsum('bhqk,bhkd->bhqd', p[..., n_sel:], v_own))

    return _sweep_query_blocks(block, q)


def causal_attention(q, k, v):
    s_len = k.shape[2]
    k_pos = jnp.arange(s_len)
    scale = q.shape[-1] ** -0.5

    def block(start, qb):
        q_pos = start + jnp.arange(Q_BLOCK)
        s = jnp.einsum('bhqd,bhkd->bhqk', qb, k).astype(jnp.float32) * scale
        s = jnp.where(k_pos[None, :] <= q_pos[:, None], s, -jnp.inf)
        p = jax.nn.softmax(s, axis=-1).astype(v.dtype)
        return jnp.einsum('bhqk,bhkd->bhqd', p, v)

    return _sweep_query_blocks(block, q)


def setup_inputs(seed: int = 0) -> dict:
    key = jax.random.key(seed)
    ks = jax.random.split(key, 20)
    f32 = jnp.float32
    L = DEPTH

    def nrm(k, shape, scale):
        return jax.random.normal(k, shape, f32) * scale

    return {
        'x': nrm(ks[0], (BATCH, SEQ, D_MODEL), 1.0),
        'w_in': nrm(ks[1], (L, D_MODEL, N_IN), D_MODEL ** -0.5),
        'b_forget': FORGET_BIAS_INIT + nrm(ks[2], (L, GROUP_HEADS), 0.1),
        'diff_lambda': nrm(ks[3], (L, 4, DIFF_QK_DIM), 0.1),
        'diff_subln': 1.0 + nrm(ks[4], (L, HEAD_DIM), 0.02),
        'mla_q_norm': 1.0 + nrm(ks[5], (L, MLA_Q_LORA), 0.02),
        'mla_kv_norm': 1.0 + nrm(ks[6], (L, MLA_KV_LORA), 0.02),
        'mla_w_uq': nrm(ks[7], (L, MLA_Q_LORA, GROUP_HEADS * (MLA_NOPE + MLA_ROPE)), MLA_Q_LORA ** -0.5),
        'mla_w_ukv': nrm(ks[8], (L, MLA_KV_LORA, GROUP_HEADS * (MLA_NOPE + MLA_V)), MLA_KV_LORA ** -0.5),
        'rel_bias': nrm(ks[9], (REL_BUCKETS, N_REL_HEADS), 0.2),
        'w_o': nrm(ks[10], (L, MIX_WIDTH, D_MODEL), MIX_WIDTH ** -0.5 * DEEPNORM_BETA),
        'ln1_g': 1.0 + nrm(ks[11], (L, D_MODEL), 0.02),
        'ln1_b': nrm(ks[12], (L, D_MODEL), 0.02),
        'w_up': nrm(ks[13], (L, D_MODEL, 2 * D_FF), D_MODEL ** -0.5),
        'conv_w': nrm(ks[14], (L, CONV_WIDTH, 2 * D_FF), CONV_WIDTH ** -0.5),
        'conv_b': nrm(ks[15], (L, 2 * D_FF), 0.02),
        'w_down': nrm(ks[16], (L, D_FF, D_MODEL), D_FF ** -0.5 * DEEPNORM_BETA),
        'ln2_g': 1.0 + nrm(ks[17], (L, D_MODEL), 0.02),
        'ln2_b': nrm(ks[18], (L, D_MODEL), 0.02),
    }


def reference(x, w_in, b_forget, diff_lambda, diff_subln, mla_q_norm, mla_kv_norm, mla_w_uq,
              mla_w_ukv, rel_bias, w_o, ln1_g, ln1_b, w_up, conv_w, conv_b, w_down, ln2_g, ln2_b):
    b, s_len, _ = x.shape
    G = GROUP_HEADS
    pos = jnp.arange(s_len)
    bias_by_dist = rel_bias[_rel_bucket(pos)].T.astype(jnp.float32)
    bias_diff, bias_moba = bias_by_dist[:G], bias_by_dist[G:]
    cos, sin = _rope_tables(s_len)

    for l in range(DEPTH):
        h = x @ w_in[l]
        fox_h, diff_h, moba_h, mla_h = jnp.split(h, list(IN_SPLITS), axis=-1)

        fq, fk, fv, ff = jnp.split(fox_h, [GROUP_WIDTH, 2 * GROUP_WIDTH, 3 * GROUP_WIDTH], axis=-1)
        log_f = jax.nn.log_sigmoid(ff.astype(jnp.float32) + b_forget[l].astype(jnp.float32)).transpose(0, 2, 1)
        fox_o = fox_attention(_heads(fq, G), _heads(fk, G), _heads(fv, G), log_f)

        lam_init = 0.8 - 0.6 * math.exp(-0.3 * l)
        lq1, lk1, lq2, lk2 = diff_lambda[l].astype(jnp.float32)
        lam = jnp.exp(jnp.sum(lq1 * lk1)) - jnp.exp(jnp.sum(lq2 * lk2)) + lam_init
        dq, dk, dv = jnp.split(diff_h, [GROUP_WIDTH, 2 * GROUP_WIDTH], axis=-1)
        dq = _heads(dq, G).reshape(b, G, s_len, 2, DIFF_QK_DIM)
        dk = _heads(dk, G).reshape(b, G, s_len, 2, DIFF_QK_DIM)
        diff_o = diff_attention(dq, dk, _heads(dv, G), lam, bias_diff)
        diff_o = _rmsnorm(diff_o, diff_subln[l], DIFF_SUBLN_EPS) * (1.0 - lam_init)

        mq, mk, mv = jnp.split(moba_h, [GROUP_WIDTH, 2 * GROUP_WIDTH], axis=-1)
        moba_o = moba_attention(_heads(mq, G), _heads(mk, G), _heads(mv, G), bias_moba)

        cq, ckv, kr = jnp.split(mla_h, [MLA_Q_LORA, MLA_Q_LORA + MLA_KV_LORA], axis=-1)
        lq = _heads(_rmsnorm(cq, mla_q_norm[l]) @ mla_w_uq[l], G)
        lkv = _heads(_rmsnorm(ckv, mla_kv_norm[l]) @ mla_w_ukv[l], G)
        q_nope, q_rope = jnp.split(lq, [MLA_NOPE], axis=-1)
        k_nope, lv = jnp.split(lkv, [MLA_NOPE], axis=-1)
        k_rope = jnp.broadcast_to(_rope(kr[:, None], cos, sin), q_rope.shape)
        mla_o = causal_attention(jnp.concatenate([q_nope, _rope(q_rope, cos, sin)], axis=-1),
                                 jnp.concatenate([k_nope, k_rope], axis=-1), lv)

        mix = jnp.concatenate([_merge(fox_o), _merge(diff_o), _merge(moba_o), _merge(mla_o)], axis=-1) @ w_o[l]
        x = _layernorm(DEEPNORM_ALPHA * x + mix, ln1_g[l], ln1_b[l])

        u = x @ w_up[l]
        u_pad = jnp.pad(u, ((0, 0), (CONV_WIDTH - 1, 0), (0, 0)))
        cw = conv_w[l]
        u = sum(cw[j] * u_pad[:, j:j + s_len] for j in range(CONV_WIDTH)) + conv_b[l]
        gate, val = jnp.split(u, 2, axis=-1)
        y = (jax.nn.silu(gate) * val) @ w_down[l]
        x = _layernorm(DEEPNORM_ALPHA * x + y, ln2_g[l], ln2_b[l])

    return x
```

```cpp
#include <hip/hip_runtime.h>
#include <hip/hip_cooperative_groups.h>
#include <stdint.h>
#include <stdio.h>
namespace cg = cooperative_groups;

typedef unsigned short bf16_t;
typedef short bf16x8 __attribute__((ext_vector_type(8)));
typedef short s16x4 __attribute__((ext_vector_type(4)));
typedef short v4i16_t __attribute__((ext_vector_type(4)));
typedef float f32x16 __attribute__((ext_vector_type(16)));
typedef float f32x4 __attribute__((ext_vector_type(4)));
typedef unsigned u32x4 __attribute__((ext_vector_type(4)));
typedef unsigned u32x2 __attribute__((ext_vector_type(2)));
#define LDSAS __attribute__((address_space(3)))

#ifndef N_LAUNCH_SPLIT
#define N_LAUNCH_SPLIT 0
#endif
#ifdef DIAG
#define PH_END 8
#define DUMP_ACT 0
#define UP_PLAIN 1
#define UP_ALIGNED 1
#define DUMP_OFF OFF_H
#define DUMP_PITCH DFFP
#endif

constexpr int T_ = 16384, S_ = 8192, DM = 1024, NIN = 2724, NINP = 2816, DFF = 2752, DFFP = 2816, NUP = 5632, NUPSRC = 5504;
constexpr int XB_ROWS = T_ + 256;
constexpr float LOG2E = 1.4426950408889634f;
constexpr float ALPHA = 1.681792830507429f;
constexpr int LDS_BYTES = 147456 + 16;
constexpr int GEMM_STAGE = 73728, GEMM_BOFF = 36864, GEMM_RS = 144;
constexpr int U_RS = 520;

constexpr size_t al256(size_t x) { return (x + 255) & ~(size_t)255; }
constexpr size_t OFF_WT_IN = 0;
constexpr size_t OFF_WT_O = OFF_WT_IN + al256((size_t)4 * NINP * DM * 2);
constexpr size_t OFF_WT_UP = OFF_WT_O + al256((size_t)4 * DM * DM * 2);
constexpr size_t OFF_WT_DN = OFF_WT_UP + al256((size_t)4 * NUP * DM * 2);
constexpr size_t OFF_WT_UQ = OFF_WT_DN + al256((size_t)4 * DM * DFFP * 2);
constexpr size_t OFF_WT_UKV = OFF_WT_UQ + al256((size_t)4 * 384 * 256 * 2);
constexpr size_t OFF_XB = OFF_WT_UKV + al256((size_t)4 * 512 * 128 * 2);
constexpr size_t OFF_H = OFF_XB + al256((size_t)XB_ROWS * DM * 2);
constexpr size_t OFF_LQ = OFF_H + al256((size_t)T_ * NINP * 2);
constexpr size_t OFF_LK = OFF_LQ + al256((size_t)T_ * 384 * 2);
constexpr size_t OFF_LV = OFF_LK + al256((size_t)T_ * 384 * 2);
constexpr size_t OFF_MIXB = OFF_LV + al256((size_t)T_ * 256 * 2);
constexpr size_t OFF_KMHI = OFF_MIXB + al256((size_t)T_ * DM * 2);
constexpr size_t OFF_KMLO = OFF_KMHI + al256((size_t)8 * 32 * 64 * 2);
constexpr size_t OFF_LOGF = OFF_KMLO + al256((size_t)8 * 32 * 64 * 2);
constexpr size_t OFF_NEGC = OFF_LOGF + al256((size_t)T_ * 4 * 4);
constexpr size_t OFF_ROPEC = OFF_NEGC + al256((size_t)8 * S_ * 4);
constexpr size_t OFF_ROPES = OFF_ROPEC + al256((size_t)S_ * 16 * 4);
constexpr size_t OFF_BUCKET = OFF_ROPES + al256((size_t)S_ * 16 * 4);
constexpr size_t OFF_COUNTERS = OFF_BUCKET + al256(128 * 4);
constexpr size_t OFF_NORMS = OFF_COUNTERS + al256(64 * 4);
constexpr size_t OFF_STATS = OFF_NORMS + al256(512 * 4);
constexpr size_t OFF_BAR = OFF_STATS + al256((size_t)T_ * 2 * 4);
constexpr size_t WS_NEEDED = OFF_BAR + al256(3456 * 4);

struct Params {
    const float *x, *w_in, *b_forget, *diff_lambda, *diff_subln, *mla_q_norm, *mla_kv_norm, *mla_w_uq, *mla_w_ukv, *rel_bias, *w_o,
        *ln1_g, *ln1_b, *w_up, *conv_w, *conv_b, *w_down, *ln2_g, *ln2_b;
    float* out;
    char* ws;
    float lam_init[4];
    int ph_begin, ph_end;
};

#define MFMA32(a, b, c) __builtin_amdgcn_mfma_f32_32x32x16_bf16(a, b, c, 0, 0, 0)
__device__ __forceinline__ int crow(int r, int hi) { return (r & 3) + 8 * (r >> 2) + 4 * hi; }
typedef float f32x2_ __attribute__((ext_vector_type(2)));
typedef __bf16 bf16v2_ __attribute__((ext_vector_type(2)));
__device__ __forceinline__ unsigned cvtpk(float lo, float hi) { f32x2_ v = {lo, hi}; bf16v2_ b = __builtin_convertvector(v, bf16v2_); return __builtin_bit_cast(unsigned, b); }
__device__ __forceinline__ bf16_t f2bf(float f) { return (bf16_t)(cvtpk(f, 0.f) & 0xffffu); }
__device__ __forceinline__ float bf2f(bf16_t b) { return __uint_as_float(((unsigned)b) << 16); }
__device__ __forceinline__ float bfs2f(short b) { return __uint_as_float(((unsigned)(unsigned short)b) << 16); }
__device__ __forceinline__ s16x4 vtr(const LDSAS char* p) { return __builtin_bit_cast(s16x4, __builtin_amdgcn_ds_read_tr16_b64_v4i16((LDSAS v4i16_t*)p)); }
__device__ __forceinline__ float swapmax(float v) { auto rr = __builtin_amdgcn_permlane32_swap(__float_as_uint(v), __float_as_uint(v), false, false); return fmaxf(__uint_as_float(rr[0]), __uint_as_float(rr[1])); }
__device__ __forceinline__ float swapsum(float v) { auto rr = __builtin_amdgcn_permlane32_swap(__float_as_uint(v), __float_as_uint(v), false, false); return __uint_as_float(rr[0]) + __uint_as_float(rr[1]); }
__device__ __forceinline__ float fexp2(float x) { return __builtin_amdgcn_exp2f(x); }
__device__ __forceinline__ unsigned xb_xcc_id();
__device__ __forceinline__ int otid() { int t = threadIdx.x; asm volatile("" : "+v"(t)); return t; }

__device__ __forceinline__ int src_col(int type, int n, float& sc) {
    sc = 1.f;
    if (type == 0) {
        if (n < 256) sc = 0.125f * LOG2E;
        else if (n >= 768 && n < 1024) sc = 0.17677669529663687f * LOG2E;
        else if (n >= 1536 && n < 1792) sc = 0.125f * LOG2E;
        if (n < 768) return n;
        if (n < 2720) return n + 4;
        if (n < 2724) return 768 + (n - 2720);
        return -1;
    } else if (type == 2) {
        const int pn = n >> 8, j = n & 255;
        const int c = pn * 128 + (j & 127);
        if (c >= DFF) return -1;
        return (j < 128) ? c : DFF + c;
    } else if (type == 4) {
        sc = 0.10206207261596575f * LOG2E;
        return n;
    }
    return n;
}

__device__ __forceinline__ void transpose_tile(const float* __restrict__ W, int K, int N, bf16_t* __restrict__ Wt, int Kp, int n0, int k0, int type, char* lds, const float* __restrict__ gk = nullptr) {
    const int tid = otid();
    unsigned* tl = (unsigned*)lds;
    {
        const int g = tid & 15; float sc; const int src = src_col(type, n0 + 4 * g, sc);
#pragma unroll
        for (int i = 0; i < 2; ++i) {
            const int kk = (tid >> 4) + 32 * i, k = k0 + kk;
            f32x4 v = {0.f, 0.f, 0.f, 0.f};
            if (src >= 0 && k < K) v = *(const f32x4*)(W + (size_t)k * N + src);
            const float sck = (gk && k < K) ? sc * gk[k] : sc;
            tl[kk * 33 + 2 * g] = cvtpk(v[0] * sck, v[1] * sck);
            tl[kk * 33 + 2 * g + 1] = cvtpk(v[2] * sck, v[3] * sck);
        }
    }
    __syncthreads();
    {
        const int nn = tid >> 3, c = tid & 7;
        const unsigned short* t16 = (const unsigned short*)lds;
        unsigned w[4];
#pragma unroll
        for (int j = 0; j < 4; ++j) {
            const unsigned lo = t16[(c * 8 + 2 * j) * 66 + nn], hi_ = t16[(c * 8 + 2 * j + 1) * 66 + nn];
            w[j] = lo | (hi_ << 16);
        }
        *(u32x4*)(Wt + (size_t)(n0 + nn) * Kp + k0 + c * 8) = (u32x4){w[0], w[1], w[2], w[3]};
    }
    __syncthreads();
}

__device__ __forceinline__ void phase_prologue(const Params& p, char* lds) {
    const int tid = otid(), nb = gridDim.x, bid = blockIdx.x;
    for (int t = bid; t < 4 * 3112; t += nb) {
        const int l = t / 3112; int r = t % 3112;
        if (r < 704) { const int nt = r / 16, kt = r % 16; transpose_tile(p.w_in + (size_t)l * DM * NIN, DM, NIN, ((bf16_t*)(p.ws + OFF_WT_IN)) + (size_t)l * NINP * DM, DM, nt * 64, kt * 64, 0, lds); continue; }
        r -= 704;
        if (r < 256) { const int nt = r / 16, kt = r % 16; transpose_tile(p.w_o + (size_t)l * DM * DM, DM, DM, ((bf16_t*)(p.ws + OFF_WT_O)) + (size_t)l * DM * DM, DM, nt * 64, kt * 64, 1, lds); continue; }
        r -= 256;
        if (r < 1408) { const int nt = r / 16, kt = r % 16; transpose_tile(p.w_up + (size_t)l * DM * NUPSRC, DM, NUPSRC, ((bf16_t*)(p.ws + OFF_WT_UP)) + (size_t)l * NUP * DM, DM, nt * 64, kt * 64, 2, lds); continue; }
        r -= 1408;
        if (r < 704) { const int nt = r / 44, kt = r % 44; transpose_tile(p.w_down + (size_t)l * DFF * DM, DFF, DM, ((bf16_t*)(p.ws + OFF_WT_DN)) + (size_t)l * DM * DFFP, DFFP, nt * 64, kt * 64, 3, lds); continue; }
        r -= 704;
        if (r < 24) { const int nt = r / 4, kt = r % 4; transpose_tile(p.mla_w_uq + (size_t)l * 256 * 384, 256, 384, ((bf16_t*)(p.ws + OFF_WT_UQ)) + (size_t)l * 384 * 256, 256, nt * 64, kt * 64, 4, lds, p.mla_q_norm + l * 256); continue; }
        r -= 24;
        { const int nt = r / 2, kt = r % 2; transpose_tile(p.mla_w_ukv + (size_t)l * 128 * 512, 128, 512, ((bf16_t*)(p.ws + OFF_WT_UKV)) + (size_t)l * 512 * 128, 128, nt * 64, kt * 64, 5, lds, p.mla_kv_norm + l * 128); }
    }
    const size_t gtid = (size_t)bid * 512 + tid, gn = (size_t)nb * 512;
    for (size_t i = gtid; i < (size_t)T_ * DM / 8; i += gn) {
        const f32x4 a = *(const f32x4*)(p.x + i * 8), b = *(const f32x4*)(p.x + i * 8 + 4);
        u32x4 w; w.x = cvtpk(a[0], a[1]); w.y = cvtpk(a[2], a[3]); w.z = cvtpk(b[0], b[1]); w.w = cvtpk(b[2], b[3]);
        *(u32x4*)(((bf16_t*)(p.ws + OFF_XB)) + i * 8) = w;
    }
    for (size_t i = gtid; i < (size_t)256 * DM / 8; i += gn) *(u32x4*)(((bf16_t*)(p.ws + OFF_XB)) + (size_t)T_ * DM + i * 8) = (u32x4){0u, 0u, 0u, 0u};
    for (size_t i = gtid; i < (size_t)S_ * 16; i += gn) {
        const int pos = (int)(i >> 4), j = (int)(i & 15);
        const float inv = exp2f(-(float)j * (2.0f / 32.0f) * 13.287712379549449f);
        const float ang = (float)pos * inv;
        const double rev = (double)ang * 0.15915494309189535;
        const double fr = rev - floor(rev);
        const float a2 = (float)(fr * 6.283185307179586);
        ((float*)(p.ws + OFF_ROPEC))[i] = cosf(a2); ((float*)(p.ws + OFF_ROPES))[i] = sinf(a2);
    }
    if (bid == 0) {
        if (tid < 128) {
            int b;
            if (tid < 16) b = tid;
            else { const float v = logf((float)tid / 16.0f) / 2.0794415416798357f * 16.0f; b = 16 + (int)v; if (b > 31) b = 31; }
            ((int*)(p.ws + OFF_BUCKET))[tid] = b;
        }
        if (tid < 64) ((unsigned*)(p.ws + OFF_COUNTERS))[tid] = 0u;
    }
}

__device__ __forceinline__ void tile_map(int t, int nM, int nN, int& pm, int& pn) {
    const int nwg = nM * nN;
    const int q = nwg / 8, r = nwg % 8, xcd = t % 8, off = t / 8;
    const int wgid = (xcd < r ? xcd * (q + 1) : r * (q + 1) + (xcd - r) * q) + off;
    const int nig = 8 * nN, gid = wgid / nig, fm = gid * 8, gsz = (nM - fm) < 8 ? (nM - fm) : 8;
    pm = fm + ((wgid % nig) % gsz); pn = (wgid % nig) / gsz;
}

__device__ __forceinline__ void gemm_tile(const bf16_t* __restrict__ A, int lda, const bf16_t* __restrict__ B, int ldb, int K, char* lds, f32x16 (&acc)[4][2]) {
    const int tid = otid(), lane = tid & 63, r32 = lane & 31, hi = lane >> 5, wid = __builtin_amdgcn_readfirstlane(tid >> 6), wr = wid >> 2, wc = wid & 3;
#pragma unroll
    for (int mt = 0; mt < 4; ++mt)
#pragma unroll
        for (int nt = 0; nt < 2; ++nt)
#pragma unroll
            for (int r = 0; r < 16; ++r) acc[mt][nt][r] = 0.f;
    const bf16_t* ga = A + (size_t)(tid >> 3) * lda + (tid & 7) * 8;
    const bf16_t* gb = B + (size_t)(tid >> 3) * ldb + (tid & 7) * 8;
    const int lw = (tid >> 3) * GEMM_RS + (tid & 7) * 16;
    u32x4 ra[4], rb[4];
    const int nkt = K / 64;
#pragma unroll
    for (int i = 0; i < 4; ++i) { ra[i] = *(const u32x4*)(ga + (size_t)i * 64 * lda); rb[i] = *(const u32x4*)(gb + (size_t)i * 64 * ldb); }
#pragma unroll
    for (int i = 0; i < 4; ++i) { *(u32x4*)(lds + lw + i * 64 * GEMM_RS) = ra[i]; *(u32x4*)(lds + GEMM_BOFF + lw + i * 64 * GEMM_RS) = rb[i]; }
#pragma unroll
    for (int i = 0; i < 4; ++i) { ra[i] = *(const u32x4*)(ga + (size_t)i * 64 * lda + 64); rb[i] = *(const u32x4*)(gb + (size_t)i * 64 * ldb + 64); }
    __syncthreads();
    const int la0 = (wr * 128 + r32) * GEMM_RS + hi * 16, lb0 = GEMM_BOFF + (wc * 64 + r32) * GEMM_RS + hi * 16;
    for (int kt = 0; kt < nkt; ++kt) {
        const int buf = kt & 1;
        if (kt + 1 < nkt) {
            char* nbase = lds + (buf ^ 1) * GEMM_STAGE;
#pragma unroll
            for (int i = 0; i < 4; ++i) { *(u32x4*)(nbase + lw + i * 64 * GEMM_RS) = ra[i]; *(u32x4*)(nbase + GEMM_BOFF + lw + i * 64 * GEMM_RS) = rb[i]; }
        }
        if (kt + 2 < nkt) {
#pragma unroll
            for (int i = 0; i < 4; ++i) { ra[i] = *(const u32x4*)(ga + (size_t)i * 64 * lda + (kt + 2) * 64); rb[i] = *(const u32x4*)(gb + (size_t)i * 64 * ldb + (kt + 2) * 64); }
        }
        __builtin_amdgcn_sched_barrier(0);
        const char* base = lds + buf * GEMM_STAGE;
#pragma unroll
        for (int kk = 0; kk < 4; ++kk) {
            bf16x8 af[4], bfr[2];
#pragma unroll
            for (int mt = 0; mt < 4; ++mt) af[mt] = *(const bf16x8*)(base + la0 + mt * 32 * GEMM_RS + kk * 32);
#pragma unroll
            for (int nt = 0; nt < 2; ++nt) bfr[nt] = *(const bf16x8*)(base + lb0 + nt * 32 * GEMM_RS + kk * 32);
#pragma unroll
            for (int mt = 0; mt < 4; ++mt)
#pragma unroll
                for (int nt = 0; nt < 2; ++nt) acc[mt][nt] = MFMA32(bfr[nt], af[mt], acc[mt][nt]);
        }
        __syncthreads();
    }
}

__device__ __forceinline__ void stage_acc(const f32x16 (&acc)[4][2], char* lds) {
    const int tid = otid(), lane = tid & 63, r32 = lane & 31, hi = lane >> 5, wid = __builtin_amdgcn_readfirstlane(tid >> 6), wr = wid >> 2, wc = wid & 3;
#pragma unroll
    for (int mt = 0; mt < 4; ++mt)
#pragma unroll
        for (int nt = 0; nt < 2; ++nt)
#pragma unroll
            for (int g = 0; g < 4; ++g) {
                const int t = wr * 128 + mt * 32 + r32, n = wc * 64 + nt * 32 + 8 * g + 4 * hi;
                u32x2 w; w.x = cvtpk(acc[mt][nt][4 * g], acc[mt][nt][4 * g + 1]); w.y = cvtpk(acc[mt][nt][4 * g + 2], acc[mt][nt][4 * g + 3]);
                *(u32x2*)(lds + t * U_RS + n * 2) = w;
            }
    __syncthreads();
}

__device__ __forceinline__ void phase_inproj(const Params& p, int l, char* lds) {
    const int tid = otid(), lane = tid & 63, r32 = lane & 31, hi = lane >> 5, wid = __builtin_amdgcn_readfirstlane(tid >> 6), wr = wid >> 2, wc = wid & 3;
    const bf16_t* Wt = ((bf16_t*)(p.ws + OFF_WT_IN)) + (size_t)l * NINP * DM;
    for (int t = blockIdx.x; t < 64 * 11; t += gridDim.x) {
        int pm, pn; tile_map(t, 64, 11, pm, pn);
        f32x16 acc[4][2];
        gemm_tile(((bf16_t*)(p.ws + OFF_XB)) + (size_t)pm * 256 * DM, DM, Wt + (size_t)pn * 256 * DM, DM, DM, lds, acc);
        if (pn == 10 && wc == 2 && hi == 0) {
            const f32x4 bfv = *(const f32x4*)(p.b_forget + l * 4);
#pragma unroll
            for (int mt = 0; mt < 4; ++mt) {
                const int tok = pm * 256 + wr * 128 + mt * 32 + r32;
                f32x4 o;
#pragma unroll
                for (int j = 0; j < 4; ++j) { const float xv = acc[mt][1][j] + bfv[j]; o[j] = fminf(xv, 0.f) - log1pf(expf(-fabsf(xv))); }
                *(f32x4*)(((float*)(p.ws + OFF_LOGF)) + (size_t)tok * 4) = o;
            }
        }
        stage_acc(acc, lds);
#pragma unroll 4
        for (int i = 0; i < 32; ++i) {
            const int tl = wid + 8 * i;
            const u32x2 v = *(const u32x2*)(lds + tl * U_RS + lane * 8);
            *(u32x2*)(((bf16_t*)(p.ws + OFF_H)) + (size_t)(pm * 256 + tl) * NINP + pn * 256 + lane * 4) = v;
        }
        float* red = (float*)(lds + 135168);
        const int bq = pm >> 5, blk = pm & 31;
        if (pn == 7) {
            const int col = tid & 255, half = tid >> 8;
            float sum = 0.f;
#pragma unroll 8
            for (int r = 0; r < 128; ++r) sum += bf2f(*(const bf16_t*)(lds + (half * 128 + r) * U_RS + col * 2));
            red[half * 256 + col] = sum;
            __syncthreads();
            if (tid < 256) {
                const float mean = (red[tid] + red[256 + tid]) * (1.0f / 256.0f);
                const int hd = tid >> 6, d = tid & 63;
                const bf16_t hb = f2bf(mean);
                ((bf16_t*)(p.ws + OFF_KMHI))[(((size_t)(bq * 4 + hd)) * 32 + blk) * 64 + d] = hb;
                ((bf16_t*)(p.ws + OFF_KMLO))[(((size_t)(bq * 4 + hd)) * 32 + blk) * 64 + d] = f2bf(mean - bf2f(hb));
            }
        } else if (pn <= 1) {
            const int row = tid & 255, hp = tid >> 8;
            float n0_ = 0.f, n1_ = 0.f;
#pragma unroll 4
            for (int c = 0; c < 16; ++c) {
                const u32x2 a = *(const u32x2*)(lds + row * U_RS + (hp * 128) * 2 + c * 8), b_ = *(const u32x2*)(lds + row * U_RS + (hp * 128 + 64) * 2 + c * 8);
                const float a0 = __uint_as_float(a.x << 16), a1 = __uint_as_float(a.x & 0xffff0000u), a2 = __uint_as_float(a.y << 16), a3 = __uint_as_float(a.y & 0xffff0000u);
                const float b0 = __uint_as_float(b_.x << 16), b1 = __uint_as_float(b_.x & 0xffff0000u), b2 = __uint_as_float(b_.y << 16), b3 = __uint_as_float(b_.y & 0xffff0000u);
                n0_ += a0 * a0 + a1 * a1 + a2 * a2 + a3 * a3; n1_ += b0 * b0 + b1 * b1 + b2 * b2 + b3 * b3;
            }
#pragma unroll
            for (int o_ = 32; o_ >= 1; o_ >>= 1) { n0_ = fmaxf(n0_, __shfl_xor(n0_, o_)); n1_ = fmaxf(n1_, __shfl_xor(n1_, o_)); }
            if (lane == 0) { red[wid * 2] = n0_; red[wid * 2 + 1] = n1_; }
            __syncthreads();
            if (tid < 4) {
                const int hpw = tid >> 1, which = tid & 1;
                float m_ = 0.f;
                for (int w = 0; w < 4; ++w) m_ = fmaxf(m_, red[(hpw * 4 + w) * 2 + which]);
                ((float*)(p.ws + OFF_NORMS))[pn * 256 + (bq * 4 + tid) * 32 + blk] = m_;
            }
        }
        __syncthreads();
    }
}

__device__ __forceinline__ void phase_resgemm(const Params& p, const bf16_t* A, int lda, const bf16_t* Wt, int K, char* lds, const float* __restrict__ rg, const float* __restrict__ rb, const float* __restrict__ rsrc) {
    const int tid = otid(), lane = tid & 63, r32 = lane & 31, hi = lane >> 5, wid = __builtin_amdgcn_readfirstlane(tid >> 6), wr = wid >> 2, wc = wid & 3;
    constexpr int RS = 260;
    float* stg = (float*)lds;
    for (int t = blockIdx.x; t < 64 * 4; t += gridDim.x) {
        int pm, pn; tile_map(t, 64, 4, pm, pn);
        f32x16 acc[4][2];
        gemm_tile(A + (size_t)pm * 256 * lda, lda, Wt + (size_t)pn * 256 * K, K, K, lds, acc);
        f32x4 gr = {1.f, 1.f, 1.f, 1.f}, br = {0.f, 0.f, 0.f, 0.f};
        if (rg) { gr = *(const f32x4*)(rg + pn * 256 + lane * 4); br = *(const f32x4*)(rb + pn * 256 + lane * 4); }
#pragma unroll
        for (int mt = 0; mt < 4; ++mt) {
#pragma unroll
            for (int nt = 0; nt < 2; ++nt)
#pragma unroll
                for (int g = 0; g < 4; ++g) {
                    f32x4 v = {acc[mt][nt][4 * g], acc[mt][nt][4 * g + 1], acc[mt][nt][4 * g + 2], acc[mt][nt][4 * g + 3]};
                    *(f32x4*)(stg + (wr * 32 + r32) * RS + wc * 64 + nt * 32 + 8 * g + 4 * hi) = v;
                }
            __syncthreads();
#pragma unroll
            for (int i = 0; i < 8; ++i) {
                const int lr = wid * 8 + i;
                const int tok = pm * 256 + (lr >> 5) * 128 + mt * 32 + (lr & 31);
                float* px = p.out + (size_t)tok * DM + pn * 256 + lane * 4;
                f32x4 xv = *(const f32x4*)(rsrc + (size_t)tok * DM + pn * 256 + lane * 4);
                const f32x4 av = *(const f32x4*)(stg + lr * RS + lane * 4);
                float mu = 0.f, rstd = 1.f;
                if (rg) { const float* st = ((const float*)(p.ws + OFF_STATS)) + (size_t)tok * 2; mu = st[0]; rstd = st[1]; }
#pragma unroll
                for (int j = 0; j < 4; ++j) xv[j] = ALPHA * ((xv[j] - mu) * rstd * gr[j] + br[j]) + av[j];
                *(f32x4*)px = xv;
            }
            __syncthreads();
        }
    }
}

template <bool WRITE_OUT>
__device__ __forceinline__ void phase_ln(const Params& p, const float* __restrict__ g, const float* __restrict__ b) {
    const int tid = otid(), lane = tid & 63, wid = __builtin_amdgcn_readfirstlane(tid >> 6);
    f32x4 gv[4], bv[4];
#pragma unroll
    for (int i = 0; i < 4; ++i) { gv[i] = *(const f32x4*)(g + i * 256 + lane * 4); bv[i] = *(const f32x4*)(b + i * 256 + lane * 4); }
    for (int row = blockIdx.x * 8 + wid; row < T_; row += gridDim.x * 8) {
        float* pr = p.out + (size_t)row * DM;
        f32x4 v[4]; float s = 0.f;
#pragma unroll
        for (int i = 0; i < 4; ++i) { v[i] = *(const f32x4*)(pr + i * 256 + lane * 4); s += (v[i][0] + v[i][1]) + (v[i][2] + v[i][3]); }
#pragma unroll
        for (int o = 32; o >= 1; o >>= 1) s += __shfl_xor(s, o);
        const float mu = s * (1.0f / 1024.0f);
        float q = 0.f;
#pragma unroll
        for (int i = 0; i < 4; ++i)
#pragma unroll
            for (int j = 0; j < 4; ++j) { const float d = v[i][j] - mu; q += d * d; }
#pragma unroll
        for (int o = 32; o >= 1; o >>= 1) q += __shfl_xor(q, o);
        const float rstd = rsqrtf(q * (1.0f / 1024.0f) + 1e-5f);
        if (!WRITE_OUT && lane == 0) { float* st = ((float*)(p.ws + OFF_STATS)) + (size_t)row * 2; st[0] = mu; st[1] = rstd; }
#pragma unroll
        for (int i = 0; i < 4; ++i) {
            f32x4 y;
#pragma unroll
            for (int j = 0; j < 4; ++j) y[j] = (v[i][j] - mu) * rstd * gv[i][j] + bv[i][j];
            if (WRITE_OUT) *(f32x4*)(pr + i * 256 + lane * 4) = y;
            u32x2 w; w.x = cvtpk(y[0], y[1]); w.y = cvtpk(y[2], y[3]);
            *(u32x2*)(((bf16_t*)(p.ws + OFF_XB)) + (size_t)row * DM + i * 256 + lane * 4) = w;
        }
    }
}

__device__ __forceinline__ void phase_up(const Params& p, int l, char* lds) {
    const int tid = otid();
    const bf16_t* Wt = ((bf16_t*)(p.ws + OFF_WT_UP)) + (size_t)l * NUP * DM;
    const float* cw = p.conv_w + (size_t)l * 3 * NUPSRC;
    const float* cb = p.conv_b + (size_t)l * NUPSRC;
    bf16_t* act = ((bf16_t*)(p.ws + OFF_H));
    for (int t = blockIdx.x; t < 66 * 22; t += gridDim.x) {
        int pm, pn; tile_map(t, 66, 22, pm, pn);
#ifdef UP_ALIGNED
        if (pm >= 64) continue;
        const int b = pm / 32, ii = pm % 32;
        const int r0 = pm * 256, lo = 0, bend = (b + 1) * S_;
#else
        const int b = pm / 33, ii = pm % 33;
        const int r0 = b * S_ + 254 * ii, lo = ii == 0 ? 0 : 2, bend = (b + 1) * S_;
#endif
        f32x16 acc[4][2];
        gemm_tile(((bf16_t*)(p.ws + OFF_XB)) + (size_t)r0 * DM, DM, Wt + (size_t)pn * 256 * DM, DM, DM, lds, acc);
        stage_acc(acc, lds);
        const int cg_ = tid & 31, ch = pn * 128 + 4 * cg_;
        const bool chv = ch < DFF;
        f32x4 wg[3], wv[3], bg, bvv;
        if (chv) {
#pragma unroll
            for (int j = 0; j < 3; ++j) { wg[j] = *(const f32x4*)(cw + j * NUPSRC + ch); wv[j] = *(const f32x4*)(cw + j * NUPSRC + DFF + ch); }
            bg = *(const f32x4*)(cb + ch); bvv = *(const f32x4*)(cb + DFF + ch);
        } else {
#pragma unroll
            for (int j = 0; j < 3; ++j) { wg[j] = (f32x4){0.f, 0.f, 0.f, 0.f}; wv[j] = wg[j]; }
            bg = (f32x4){0.f, 0.f, 0.f, 0.f}; bvv = bg;
        }
#pragma unroll 2
        for (int i = 0; i < 16; ++i) {
            const int tl = (tid >> 5) + 16 * i, tok = r0 + tl;
            if (tl >= lo && tok < bend) {
                f32x4 ag = bg, av = bvv;
#pragma unroll
                for (int j = 0; j < 3; ++j) {
                    const int ts = tl - 2 + j;
                    if (ts >= 0) {
                        const u32x2 ug = *(const u32x2*)(lds + ts * U_RS + cg_ * 8), uv = *(const u32x2*)(lds + ts * U_RS + 256 + cg_ * 8);
                        ag[0] += wg[j][0] * __uint_as_float(ug.x << 16); ag[1] += wg[j][1] * __uint_as_float(ug.x & 0xffff0000u);
                        ag[2] += wg[j][2] * __uint_as_float(ug.y << 16); ag[3] += wg[j][3] * __uint_as_float(ug.y & 0xffff0000u);
                        av[0] += wv[j][0] * __uint_as_float(uv.x << 16); av[1] += wv[j][1] * __uint_as_float(uv.x & 0xffff0000u);
                        av[2] += wv[j][2] * __uint_as_float(uv.y << 16); av[3] += wv[j][3] * __uint_as_float(uv.y & 0xffff0000u);
                    }
                }
                float o[4];
#ifdef UP_PLAIN
                { const u32x2 ug = *(const u32x2*)(lds + tl * U_RS + cg_ * 8); o[0] = __uint_as_float(ug.x << 16); o[1] = __uint_as_float(ug.x & 0xffff0000u); o[2] = __uint_as_float(ug.y << 16); o[3] = __uint_as_float(ug.y & 0xffff0000u); }
#else
#pragma unroll
                for (int j = 0; j < 4; ++j) { const float gte = ag[j]; o[j] = gte * __builtin_amdgcn_rcpf(1.f + __expf(-gte)) * av[j]; }
#endif
                u32x2 w; w.x = cvtpk(o[0], o[1]); w.y = cvtpk(o[2], o[3]);
                if (!chv) { w.x = 0u; w.y = 0u; }
                *(u32x2*)(act + (size_t)tok * DFFP + ch) = w;
            }
        }
        __syncthreads();
    }
}

__device__ __forceinline__ void store4(bf16_t* dst, const f32x16& c, int g) {
    u32x2 w; w.x = cvtpk(c[4 * g], c[4 * g + 1]); w.y = cvtpk(c[4 * g + 2], c[4 * g + 3]); *(u32x2*)dst = w;
}

__device__ __forceinline__ bf16x8 norm_frag(const bf16_t* src, const float* gn, float rstd) {
    const bf16x8 a = *(const bf16x8*)src;
    const f32x4 g0 = *(const f32x4*)gn, g1 = *(const f32x4*)(gn + 4);
    u32x4 w;
    w.x = cvtpk(bfs2f(a[0]) * rstd * g0[0], bfs2f(a[1]) * rstd * g0[1]); w.y = cvtpk(bfs2f(a[2]) * rstd * g0[2], bfs2f(a[3]) * rstd * g0[3]);
    w.z = cvtpk(bfs2f(a[4]) * rstd * g1[0], bfs2f(a[5]) * rstd * g1[1]); w.w = cvtpk(bfs2f(a[6]) * rstd * g1[2], bfs2f(a[7]) * rstd * g1[3]);
    return __builtin_bit_cast(bf16x8, w);
}

__device__ __forceinline__ void mla_stage2(const Params& p, int l, int task) {
    const int lane = otid() & 63, r32 = lane & 31, hi = lane >> 5;
    const int tt = task >> 2, part = task & 3;
    const int token = tt * 32 + r32, pos = token & (S_ - 1);
    const bf16_t* hrow = ((bf16_t*)(p.ws + OFF_H)) + (size_t)token * NINP;
    if (part < 2) {
        bf16x8 a[16]; float ss = 0.f;
#pragma unroll
        for (int kk = 0; kk < 16; ++kk) a[kk] = *(const bf16x8*)(hrow + 2304 + kk * 16 + hi * 8);
#pragma unroll
        for (int kk = 0; kk < 16; ++kk)
#pragma unroll
            for (int j = 0; j < 8; ++j) { const float f = bfs2f(a[kk][j]); ss += f * f; }
        ss = swapsum(ss);
        const float rstd = rsqrtf(ss * (1.0f / 256.0f) + 1e-6f);
        const bf16_t* W = ((bf16_t*)(p.ws + OFF_WT_UQ)) + (size_t)l * 384 * 256;
#pragma unroll 1
        for (int tg = 0; tg < 2; ++tg) {
            const int tile0 = part * 6 + tg * 3;
            f32x16 c[3];
#pragma unroll
            for (int q = 0; q < 3; ++q)
#pragma unroll
                for (int r = 0; r < 16; ++r) c[q][r] = 0.f;
#pragma unroll
            for (int kk = 0; kk < 16; ++kk) {
                if ((kk & 3) == 0) __builtin_amdgcn_sched_barrier(0);
#pragma unroll
                for (int q = 0; q < 3; ++q) {
                    const bf16x8 wf = *(const bf16x8*)(W + (size_t)((tile0 + q) * 32 + r32) * 256 + kk * 16 + hi * 8);
                    c[q] = MFMA32(wf, a[kk], c[q]);
                }
            }
#pragma unroll
            for (int q = 0; q < 3; ++q) {
#pragma unroll
                for (int r = 0; r < 16; ++r) c[q][r] *= rstd;
                const int tile = tile0 + q, head = tile / 3, sub = tile % 3;
                if (q == 2) {
                    const f32x4 c0 = *(const f32x4*)(((float*)(p.ws + OFF_ROPEC)) + pos * 16 + 4 * hi), c1 = *(const f32x4*)(((float*)(p.ws + OFF_ROPEC)) + pos * 16 + 8 + 4 * hi);
                    const f32x4 s0 = *(const f32x4*)(((float*)(p.ws + OFF_ROPES)) + pos * 16 + 4 * hi), s1 = *(const f32x4*)(((float*)(p.ws + OFF_ROPES)) + pos * 16 + 8 + 4 * hi);
#pragma unroll
                    for (int r = 0; r < 8; ++r) {
                        const float cs = r < 4 ? c0[r & 3] : c1[r & 3], sn = r < 4 ? s0[r & 3] : s1[r & 3];
                        const float t1 = c[q][r], t2 = c[q][r + 8];
                        c[q][r] = t1 * cs - t2 * sn; c[q][r + 8] = t2 * cs + t1 * sn;
                    }
                }
                bf16_t* dst = ((bf16_t*)(p.ws + OFF_LQ)) + (size_t)token * 384 + head * 96 + sub * 32 + 4 * hi;
#pragma unroll
                for (int g = 0; g < 4; ++g) store4(dst + 8 * g, c[q], g);
            }
        }
    } else {
        bf16x8 a[8]; float ss = 0.f;
#pragma unroll
        for (int kk = 0; kk < 8; ++kk) a[kk] = *(const bf16x8*)(hrow + 2560 + kk * 16 + hi * 8);
#pragma unroll
        for (int kk = 0; kk < 8; ++kk)
#pragma unroll
            for (int j = 0; j < 8; ++j) { const float f = bfs2f(a[kk][j]); ss += f * f; }
        ss = swapsum(ss);
        const float rstd = rsqrtf(ss * (1.0f / 128.0f) + 1e-6f);
        const bf16_t* W = ((bf16_t*)(p.ws + OFF_WT_UKV)) + (size_t)l * 512 * 128;
#pragma unroll 1
        for (int tg = 0; tg < 2; ++tg) {
            const int tile0 = (part - 2) * 8 + tg * 4;
            f32x16 c[4];
#pragma unroll
            for (int q = 0; q < 4; ++q)
#pragma unroll
                for (int r = 0; r < 16; ++r) c[q][r] = 0.f;
#pragma unroll
            for (int kk = 0; kk < 8; ++kk) {
                if ((kk & 1) == 0) __builtin_amdgcn_sched_barrier(0);
#pragma unroll
                for (int q = 0; q < 4; ++q) {
                    const bf16x8 wf = *(const bf16x8*)(W + (size_t)((tile0 + q) * 32 + r32) * 128 + kk * 16 + hi * 8);
                    c[q] = MFMA32(wf, a[kk], c[q]);
                }
            }
#pragma unroll
            for (int q = 0; q < 4; ++q) {
#pragma unroll
                for (int r = 0; r < 16; ++r) c[q][r] *= rstd;
                const int tile = tile0 + q, head = tile / 4, sub = q;
                bf16_t* dst = (sub < 2) ? (((bf16_t*)(p.ws + OFF_LK)) + (size_t)token * 384 + head * 96 + sub * 32 + 4 * hi) : (((bf16_t*)(p.ws + OFF_LV)) + (size_t)token * 256 + head * 64 + (sub - 2) * 32 + 4 * hi);
#pragma unroll
                for (int g = 0; g < 4; ++g) store4(dst + 8 * g, c[q], g);
            }
        }
        if (part == 3) {
            const bf16x8 x1 = *(const bf16x8*)(hrow + 2688 + hi * 8), x2 = *(const bf16x8*)(hrow + 2688 + 16 + hi * 8);
            const f32x4 c0 = *(const f32x4*)(((float*)(p.ws + OFF_ROPEC)) + pos * 16 + 8 * hi), c1 = *(const f32x4*)(((float*)(p.ws + OFF_ROPEC)) + pos * 16 + 8 * hi + 4);
            const f32x4 s0 = *(const f32x4*)(((float*)(p.ws + OFF_ROPES)) + pos * 16 + 8 * hi), s1 = *(const f32x4*)(((float*)(p.ws + OFF_ROPES)) + pos * 16 + 8 * hi + 4);
            float o1[8], o2[8];
#pragma unroll
            for (int j = 0; j < 8; ++j) {
                const float cs = j < 4 ? c0[j & 3] : c1[j & 3], sn = j < 4 ? s0[j & 3] : s1[j & 3];
                const float a1 = bfs2f(x1[j]), a2 = bfs2f(x2[j]);
                o1[j] = a1 * cs - a2 * sn; o2[j] = a2 * cs + a1 * sn;
            }
            u32x4 w1, w2;
            w1.x = cvtpk(o1[0], o1[1]); w1.y = cvtpk(o1[2], o1[3]); w1.z = cvtpk(o1[4], o1[5]); w1.w = cvtpk(o1[6], o1[7]);
            w2.x = cvtpk(o2[0], o2[1]); w2.y = cvtpk(o2[2], o2[3]); w2.z = cvtpk(o2[4], o2[5]); w2.w = cvtpk(o2[6], o2[7]);
#pragma unroll
            for (int hh = 0; hh < 4; ++hh) {
                bf16_t* d = ((bf16_t*)(p.ws + OFF_LK)) + (size_t)token * 384 + hh * 96 + 64 + hi * 8;
                *(u32x4*)d = w1; *(u32x4*)(d + 16) = w2;
            }
        }
    }
}

__device__ __forceinline__ void phase_small(const Params& p, int l, char* lds) {
    float* fl = (float*)lds;
    for (int task = blockIdx.x; task < 8 + 256; task += gridDim.x) {
        const int tid = otid(), lane = tid & 63, wid = __builtin_amdgcn_readfirstlane(tid >> 6);
        if (task < 8) {
            const int b = task >> 2, hd = task & 3;
            float v[16]; float run = 0.f;
#pragma unroll
            for (int i = 0; i < 16; ++i) { run += ((float*)(p.ws + OFF_LOGF))[((size_t)b * S_ + tid * 16 + i) * 4 + hd]; v[i] = run; }
            float sc = run;
#pragma unroll
            for (int o = 1; o < 64; o <<= 1) { const float t = __shfl_up(sc, o); if (lane >= o) sc += t; }
            if (lane == 63) fl[wid] = sc;
            __syncthreads();
            float woff = 0.f;
            for (int w = 0; w < wid; ++w) woff += fl[w];
            const float base = woff + sc - run;
#pragma unroll
            for (int i = 0; i < 16; ++i) ((float*)(p.ws + OFF_NEGC))[(size_t)task * S_ + tid * 16 + i] = -(base + v[i]) * LOG2E;
            __syncthreads();
        } else {
            mla_stage2(p, l, (task - 8) * 8 + wid);
        }
    }
}

template <int DQK, int MODE>
__device__ __forceinline__ void attn_core(const bf16_t* __restrict__ Qp, int qpitch, const bf16_t* __restrict__ Kp, int kpitch, const bf16_t* __restrict__ Vp, int vpitch,
                                          int qb, char* lds, f32x16 (&o)[2], const float* __restrict__ negc, const float* btab, unsigned sel, const float* __restrict__ norms = nullptr) {
    constexpr int NCH = DQK / 8, KRS = DQK * 2 + 16, KBUF = 64 * KRS, VBUF = 8192, BUFSZ = KBUF + VBUF + 256;
    const int tid = otid(), lane = tid & 63, r32 = lane & 31, hi = lane >> 5, wid = __builtin_amdgcn_readfirstlane(tid >> 6);
    const int q0w = qb * 256 + wid * 32, qrow = q0w + r32, NT = 4 * qb + 4;
    bf16x8 qf[DQK / 16];
#pragma unroll
    for (int d0 = 0; d0 < DQK / 16; ++d0) qf[d0] = *(const bf16x8*)(Qp + (size_t)qrow * qpitch + d0 * 16 + hi * 8);
#pragma unroll
    for (int r = 0; r < 16; ++r) { o[0][r] = 0.f; o[1][r] = 0.f; }
    float m = -1e30f, l = 0.f;
    const int kkey0 = tid / NCH, kc0 = tid % NCH;
    const int p1 = tid + 512, kkey1 = p1 / NCH, kc1 = p1 % NCH;
    const bool k0v = tid < 64 * NCH, k1v = p1 < 64 * NCH;
    const int vkey = tid >> 3, vc = tid & 7;
    const int vdst = (vc >> 2) * 4096 + vkey * 64 + (vc & 3) * 16;
    u32x4 rk0, rk1, rv; float rbias = 0.f;
    rk0 = (u32x4){0u, 0u, 0u, 0u}; rk1 = rk0;
#define ATT_LOAD(j) do { \
        if (k0v) rk0 = *(const u32x4*)(Kp + (size_t)((j) * 64 + kkey0) * kpitch + kc0 * 8); \
        if (k1v) rk1 = *(const u32x4*)(Kp + (size_t)((j) * 64 + kkey1) * kpitch + kc1 * 8); \
        rv = *(const u32x4*)(Vp + (size_t)((j) * 64 + vkey) * vpitch + vc * 8); \
        if (MODE == 1 && tid < 64) rbias = negc[(j) * 64 + tid]; } while (0)
#define ATT_STORE(bufi) do { char* bb = lds + (bufi) * BUFSZ; \
        if (k0v) *(u32x4*)(bb + kkey0 * KRS + kc0 * 16) = rk0; \
        if (k1v) *(u32x4*)(bb + kkey1 * KRS + kc1 * 16) = rk1; \
        *(u32x4*)(bb + KBUF + vdst) = rv; \
        if (MODE == 1 && tid < 64) *(float*)(bb + KBUF + VBUF + tid * 4) = rbias; } while (0)
    int j0 = 0;
    if (MODE == 1) {
        float qv = norms[lane & 31], kv = norms[256 + (lane & 31)];
#pragma unroll
        for (int o_ = 16; o_ >= 1; o_ >>= 1) { qv = fmaxf(qv, __shfl_xor(qv, o_)); kv = fmaxf(kv, __shfl_xor(kv, o_)); }
        const float qk2 = 2.0f * sqrtf(qv * kv) * 1.0001f + 1.0f;
        const float nq0 = negc[qb * 256];
        const int ja = lane, jb = lane + 64;
        const bool sa = (ja < NT - 4) && (negc[min(ja, NT - 1) * 64 + 63] - nq0 + qk2 < -160.f);
        const bool sb = (jb < NT - 4) && (negc[min(jb, NT - 1) * 64 + 63] - nq0 + qk2 < -160.f);
        const unsigned long long ba = __ballot(sa), bb = __ballot(sb);
        int cnt = (ba == ~0ull) ? 64 + (int)__builtin_ctzll(~bb | (1ull << 63)) : (int)__builtin_ctzll(~ba);
        if (bb == ~0ull && ba == ~0ull) cnt = 128;
        j0 = __builtin_amdgcn_readfirstlane(cnt);
    }
    ATT_LOAD(j0); ATT_STORE(j0 & 1);
    __syncthreads();
    const float c31 = (MODE >= 2) ? btab[127] : 0.f;
    float cref = c31;
    const int vlane = ((lane >> 4) & 1) * 32 + (lane & 3) * 8 + (4 * hi + ((lane & 15) >> 2)) * 64;
    for (int j = j0; j < NT; ++j) {
        const int buf = j & 1;
        if (j + 1 < NT) ATT_LOAD(j + 1);
        __builtin_amdgcn_sched_barrier(0);
        const int kbase = j * 64;
        bool active = kbase <= q0w + 31;
        bool selected = true;
        if (MODE == 3) { const int blk = j >> 2; if (blk < qb) { selected = (sel >> blk) & 1u; active = active && (__ballot(selected) != 0ull); } }
        if (active) {
            const char* kb = lds + buf * BUFSZ;
            f32x16 s0, s1;
            if (MODE == 1) {
                const float* nb = (const float*)(kb + KBUF + VBUF);
#pragma unroll
                for (int g = 0; g < 4; ++g) { const f32x4 t0 = *(const f32x4*)(nb + 8 * g + 4 * hi), t1 = *(const f32x4*)(nb + 32 + 8 * g + 4 * hi);
#pragma unroll
                    for (int i = 0; i < 4; ++i) { s0[4 * g + i] = t0[i]; s1[4 * g + i] = t1[i]; } }
#pragma unroll
                for (int d0 = 0; d0 < DQK / 16; ++d0) {
                    const bf16x8 kf0 = *(const bf16x8*)(kb + r32 * KRS + d0 * 32 + hi * 16), kf1 = *(const bf16x8*)(kb + (32 + r32) * KRS + d0 * 32 + hi * 16);
                    s0 = MFMA32(kf0, qf[d0], s0); s1 = MFMA32(kf1, qf[d0], s1);
                }
                if (kbase + 63 > q0w) {
#pragma unroll
                    for (int r = 0; r < 16; ++r) { const int key = kbase + crow(r, hi); if (key > qrow) s0[r] = -INFINITY; if (key + 32 > qrow) s1[r] = -INFINITY; }
                }
                float mx = fmaxf(s0[0], s1[0]);
#pragma unroll
                for (int r = 1; r < 16; ++r) mx = fmaxf(mx, fmaxf(s0[r], s1[r]));
                mx = swapmax(mx);
                const float mn = fmaxf(m, mx);
                if (__any(mn > m)) {
                    const float a = fexp2(m - mn);
                    l *= a;
#pragma unroll
                    for (int r = 0; r < 16; ++r) { o[0][r] *= a; o[1][r] *= a; }
                }
                m = mn;
                float ls = 0.f;
#pragma unroll
                for (int r = 0; r < 16; ++r) { s0[r] = fexp2(s0[r] - m); s1[r] = fexp2(s1[r] - m); ls += s0[r] + s1[r]; }
                l += ls;
            } else {
                f32x16 ci;
                {
                    const float cv = (MODE == 3 && !selected) ? -INFINITY : cref;
#pragma unroll
                    for (int r = 0; r < 16; ++r) ci[r] = cv;
                }
                {
                    const bf16x8 kf0 = *(const bf16x8*)(kb + r32 * KRS + hi * 16), kf1 = *(const bf16x8*)(kb + (32 + r32) * KRS + hi * 16);
                    s0 = MFMA32(kf0, qf[0], ci); s1 = MFMA32(kf1, qf[0], ci);
                }
#pragma unroll
                for (int d0 = 1; d0 < DQK / 16; ++d0) {
                    const bf16x8 kf0 = *(const bf16x8*)(kb + r32 * KRS + d0 * 32 + hi * 16), kf1 = *(const bf16x8*)(kb + (32 + r32) * KRS + d0 * 32 + hi * 16);
                    s0 = MFMA32(kf0, qf[d0], s0); s1 = MFMA32(kf1, qf[d0], s1);
                }
                if (MODE == 0) {
                    if (kbase + 63 > q0w) {
#pragma unroll
                        for (int r = 0; r < 16; ++r) { const int key = kbase + crow(r, hi); if (key > qrow) s0[r] = -INFINITY; if (key + 32 > qrow) s1[r] = -INFINITY; }
                    }
                } else {
                    if (!(q0w - (kbase + 63) >= 127)) {
#pragma unroll
                        for (int r = 0; r < 16; ++r) {
                            const int d0_ = qrow - (kbase + crow(r, hi)), d1_ = d0_ - 32;
                            const float b0 = btab[min(max(d0_, 0), 127)] - c31, b1 = btab[min(max(d1_, 0), 127)] - c31;
                            s0[r] = (d0_ < 0) ? -INFINITY : s0[r] + b0;
                            s1[r] = (d1_ < 0) ? -INFINITY : s1[r] + b1;
                        }
                    }
                }
                float mx = fmaxf(s0[0], s1[0]);
#pragma unroll
                for (int r = 1; r < 16; ++r) mx = fmaxf(mx, fmaxf(s0[r], s1[r]));
                mx = swapmax(mx);
                if (__any(mx > 8.0f)) {
                    const float dlt = fmaxf(mx, 0.f), a = fexp2(-dlt);
                    l *= a;
#pragma unroll
                    for (int r = 0; r < 16; ++r) { s0[r] -= dlt; s1[r] -= dlt; o[0][r] *= a; o[1][r] *= a; }
                    cref -= dlt;
                }
                float ls = 0.f;
#pragma unroll
                for (int r = 0; r < 16; ++r) { s0[r] = fexp2(s0[r]); s1[r] = fexp2(s1[r]); ls += s0[r] + s1[r]; }
                l += ls;
            }
            u32x4 pw[4];
            pw[0] = (u32x4){cvtpk(s0[0], s0[1]), cvtpk(s0[2], s0[3]), cvtpk(s0[4], s0[5]), cvtpk(s0[6], s0[7])};
            pw[1] = (u32x4){cvtpk(s0[8], s0[9]), cvtpk(s0[10], s0[11]), cvtpk(s0[12], s0[13]), cvtpk(s0[14], s0[15])};
            pw[2] = (u32x4){cvtpk(s1[0], s1[1]), cvtpk(s1[2], s1[3]), cvtpk(s1[4], s1[5]), cvtpk(s1[6], s1[7])};
            pw[3] = (u32x4){cvtpk(s1[8], s1[9]), cvtpk(s1[10], s1[11]), cvtpk(s1[12], s1[13]), cvtpk(s1[14], s1[15])};
            const LDSAS char* vb = (const LDSAS char*)(kb + KBUF) + vlane;
#pragma unroll
            for (int kk = 0; kk < 4; ++kk) {
                const bf16x8 pf = __builtin_bit_cast(bf16x8, pw[kk]);
#pragma unroll
                for (int dh = 0; dh < 2; ++dh) {
                    const s16x4 lo_ = vtr(vb + dh * 4096 + kk * 1024), hi_ = vtr(vb + dh * 4096 + kk * 1024 + 512);
                    const bf16x8 vf = (bf16x8){lo_[0], lo_[1], lo_[2], lo_[3], hi_[0], hi_[1], hi_[2], hi_[3]};
                    o[dh] = MFMA32(vf, pf, o[dh]);
                }
            }
        }
        if (j + 1 < NT) ATT_STORE(buf ^ 1);
        __syncthreads();
    }
#undef ATT_LOAD
#undef ATT_STORE
    l = swapsum(l);
    const float rl = 1.0f / l;
#pragma unroll
    for (int r = 0; r < 16; ++r) { o[0][r] *= rl; o[1][r] *= rl; }
}

__device__ __forceinline__ void store_o(bf16_t* dst  , const f32x16 (&o)[2], int hi) {
#pragma unroll
    for (int dh = 0; dh < 2; ++dh)
#pragma unroll
        for (int g = 0; g < 4; ++g) store4(dst + 32 * dh + 8 * g + 4 * hi, o[dh], g);
}

__device__ __forceinline__ void phase_attn(const Params& p, int l, char* lds, int coff = 0) {
    const int tid = otid(), lane = tid & 63, r32 = lane & 31, hi = lane >> 5, wid = __builtin_amdgcn_readfirstlane(tid >> 6);
    float* btab_all = (float*)(lds + 65536);
    int* s_unit = (int*)(lds + 65536 + 4096);
    for (int i = tid; i < 1024; i += 512) { const int hh = i >> 7, d = i & 127; btab_all[i] = p.rel_bias[((int*)(p.ws + OFF_BUCKET))[d] * 8 + hh] * LOG2E; }
    __syncthreads();
    float lam;
    {
        const float* dl = p.diff_lambda + l * 128;
        float s1 = 0.f, s2 = 0.f;
        for (int i = 0; i < 32; ++i) { s1 += dl[i] * dl[32 + i]; s2 += dl[64 + i] * dl[96 + i]; }
        lam = expf(s1) - expf(s2) + p.lam_init[l];
    }
    const float lam_init = p.lam_init[l];
    for (int qi = 0; qi < 8; ++qi) {
        const int xq = (int)((xb_xcc_id() + (unsigned)qi) & 7u);
        const int b = xq >> 2, hd = xq & 3;
        for (;;) {
            if (tid == 0) *s_unit = (int)atomicAdd(((unsigned*)(p.ws + OFF_COUNTERS)) + coff + l * 8 + xq, 1u);
            __syncthreads();
            const int u = __builtin_amdgcn_readfirstlane(*s_unit);
            __syncthreads();
            if (u >= 128) break;
            const int qb = u < 96 ? 31 - u / 3 : 127 - u, kind = u < 96 ? u % 3 : 3;
            const bf16_t* hb = ((bf16_t*)(p.ws + OFF_H)) + (size_t)b * S_ * NINP;
            const size_t orow = ((size_t)b * S_ + qb * 256 + wid * 32 + r32) * DM;
            f32x16 o[2];
            if (kind == 3) {
#ifndef SK3
                attn_core<64, 1>(hb + hd * 64, NINP, hb + 256 + hd * 64, NINP, hb + 512 + hd * 64, NINP, qb, lds, o, ((float*)(p.ws + OFF_NEGC)) + (size_t)xq * S_, nullptr, 0u, ((float*)(p.ws + OFF_NORMS)) + xq * 32);
                store_o(((bf16_t*)(p.ws + OFF_MIXB)) + orow + hd * 64, o, hi);
#endif
            } else if (kind == 1) {
#ifndef SK1
                attn_core<96, 0>(((bf16_t*)(p.ws + OFF_LQ)) + (size_t)b * S_ * 384 + hd * 96, 384, ((bf16_t*)(p.ws + OFF_LK)) + (size_t)b * S_ * 384 + hd * 96, 384, ((bf16_t*)(p.ws + OFF_LV)) + (size_t)b * S_ * 256 + hd * 64, 256, qb, lds, o, nullptr, nullptr, 0u);
                store_o(((bf16_t*)(p.ws + OFF_MIXB)) + orow + 768 + hd * 64, o, hi);
#endif
            } else if (kind == 2) {
#ifndef SK2
                unsigned sel = 0u;
                {
                    const bf16_t* Qp = hb + 1536 + hd * 64;
                    const int qrow = qb * 256 + wid * 32 + r32;
                    f32x16 gacc;
#pragma unroll
                    for (int r = 0; r < 16; ++r) gacc[r] = 0.f;
#pragma unroll
                    for (int d0 = 0; d0 < 4; ++d0) {
                        const bf16x8 qf = *(const bf16x8*)(Qp + (size_t)qrow * NINP + d0 * 16 + hi * 8);
                        const bf16x8 kh = *(const bf16x8*)(((bf16_t*)(p.ws + OFF_KMHI)) + ((size_t)xq * 32 + r32) * 64 + d0 * 16 + hi * 8);
                        const bf16x8 kl = *(const bf16x8*)(((bf16_t*)(p.ws + OFF_KMLO)) + ((size_t)xq * 32 + r32) * 64 + d0 * 16 + hi * 8);
                        gacc = MFMA32(kh, qf, gacc); gacc = MFMA32(kl, qf, gacc);
                    }
#pragma unroll
                    for (int r = 0; r < 16; ++r) if (crow(r, hi) >= qb) gacc[r] = -INFINITY;
#pragma unroll
                    for (int it = 0; it < 3; ++it) {
                        float bv = -INFINITY; int bi = 64;
#pragma unroll
                        for (int r = 0; r < 16; ++r) if (gacc[r] > bv) { bv = gacc[r]; bi = crow(r, hi); }
                        auto rv_ = __builtin_amdgcn_permlane32_swap(__float_as_uint(bv), __float_as_uint(bv), false, false);
                        auto ri_ = __builtin_amdgcn_permlane32_swap((unsigned)bi, (unsigned)bi, false, false);
                        const float v0 = __uint_as_float(rv_[0]), v1 = __uint_as_float(rv_[1]); const int i0 = (int)ri_[0], i1 = (int)ri_[1];
                        const bool first = (v0 > v1) || (v0 == v1 && i0 < i1);
                        const float wv = first ? v0 : v1; const int wi = first ? i0 : i1;
                        if (wv > -INFINITY) {
                            sel |= 1u << wi;
#pragma unroll
                            for (int r = 0; r < 16; ++r) if (crow(r, hi) == wi) gacc[r] = -INFINITY;
                        }
                    }
                }
                attn_core<64, 3>(hb + 1536 + hd * 64, NINP, hb + 1792 + hd * 64, NINP, hb + 2048 + hd * 64, NINP, qb, lds, o, nullptr, btab_all + (4 + hd) * 128, sel);
                store_o(((bf16_t*)(p.ws + OFF_MIXB)) + orow + 512 + hd * 64, o, hi);
#endif
            } else {
#ifndef SK0
                float* park = (float*)(lds + 73728) + tid;
                attn_core<32, 2>(hb + 768 + hd * 64, NINP, hb + 1024 + hd * 64, NINP, hb + 1280 + hd * 64, NINP, qb, lds, o, nullptr, btab_all + hd * 128, 0u);
#pragma unroll
                for (int dh = 0; dh < 2; ++dh)
#pragma unroll
                    for (int r = 0; r < 16; ++r) park[(dh * 16 + r) * 512] = o[dh][r];
                attn_core<32, 2>(hb + 768 + hd * 64 + 32, NINP, hb + 1024 + hd * 64 + 32, NINP, hb + 1280 + hd * 64, NINP, qb, lds, o, nullptr, btab_all + hd * 128, 0u);
                float ss = 0.f;
#pragma unroll
                for (int dh = 0; dh < 2; ++dh)
#pragma unroll
                    for (int r = 0; r < 16; ++r) { const float v = park[(dh * 16 + r) * 512] - lam * o[dh][r]; o[dh][r] = v; ss += v * v; }
                ss = swapsum(ss);
                const float rstd = rsqrtf(ss * (1.0f / 64.0f) + 1e-5f) * (1.0f - lam_init);
                const float* sg = p.diff_subln + l * 64; asm volatile("" : "+s"(sg));
#pragma unroll
                for (int dh = 0; dh < 2; ++dh)
#pragma unroll
                    for (int g = 0; g < 4; ++g) { const f32x4 gv = *(const f32x4*)(sg + 32 * dh + 8 * g + 4 * hi);
#pragma unroll
                        for (int i = 0; i < 4; ++i) o[dh][4 * g + i] *= rstd * gv[i]; }
                store_o(((bf16_t*)(p.ws + OFF_MIXB)) + orow + 256 + hd * 64, o, hi);
#endif
            }
        }
    }
}


#define XB_TMO      128
#define XB_XCNT(j)  (256  + 64 * (j))
#define XB_XSUB(j)  (1280 + 64 * (j))
#define XB_XGEN(j)  (2304 + 64 * (j))
#define XB_TOP      3328
#define XB_TOPGEN   3392
#define XCD_BAR_WORDS 3456
#define XB_SPIN_CAP (1u << 22)
__device__ __forceinline__ unsigned xb_ld(unsigned* p)              { return __hip_atomic_load(p, __ATOMIC_RELAXED, __HIP_MEMORY_SCOPE_AGENT); }
__device__ __forceinline__ unsigned xb_add(unsigned* p, unsigned v) { return __hip_atomic_fetch_add(p, v, __ATOMIC_RELAXED, __HIP_MEMORY_SCOPE_AGENT); }
__device__ __forceinline__ unsigned xb_xcc_id() { return (unsigned)__builtin_amdgcn_s_getreg((3 << 11) | 20) & 0xFu; }
#define XB_SPIN(cond, bar) do { unsigned _sp = 0; while (cond) { __builtin_amdgcn_s_sleep(1); \
    if ((++_sp & 255u) == 0u) { if (xb_ld(&(bar)[XB_TMO])) break; if (_sp > XB_SPIN_CAP) { atomicAdd(&(bar)[XB_TMO], 1u); break; } } } } while (0)
struct XcdBarrier { unsigned* bar; unsigned x; volatile LDSAS unsigned* st; };
__device__ __forceinline__ XcdBarrier xcd_barrier_post(unsigned* bar, volatile LDSAS unsigned* st) {
    XcdBarrier b; b.bar = bar; b.x = xb_xcc_id(); b.st = st;
    if (threadIdx.x == 0) (void)xb_add(&bar[XB_XCNT(b.x)], 1u);
    return b;
}
__device__ __forceinline__ void xcd_barrier_complete(unsigned* bar, unsigned x, unsigned& nloc, unsigned& nx) {
    const unsigned G = gridDim.x * gridDim.y * gridDim.z;
    unsigned sum, cnt, mine, sp = 0u;
    for (;;) {
        sum = 0u; cnt = 0u; mine = 0u;
#pragma unroll
        for (unsigned j = 0; j < 16; ++j) { const unsigned c = xb_ld(&bar[XB_XCNT(j)]); sum += c; cnt += (c > 0u) ? 1u : 0u; mine = (j == x) ? c : mine; }
        if (sum == G) break;
        __builtin_amdgcn_s_sleep(1);
        if ((++sp & 255u) == 0u) { if (xb_ld(&bar[XB_TMO])) break; if (sp > XB_SPIN_CAP) { atomicAdd(&bar[XB_TMO], 1u); break; } }
    }
    nloc = mine > 0u ? mine : 1u; nx = cnt > 0u ? cnt : 1u;
}
__device__ __forceinline__ void xcd_barrier(const XcdBarrier& b) {
    asm volatile("s_waitcnt vmcnt(0)" ::: "memory");
    __syncthreads();
    if (threadIdx.x == 0) {
        unsigned* bar = b.bar;
        __builtin_amdgcn_s_waitcnt(0);
        unsigned nloc = b.st[0], nx = b.st[1];
        if (nloc == 0u) { xcd_barrier_complete(bar, b.x, nloc, nx); b.st[0] = nloc; b.st[1] = nx; }
        const unsigned old = xb_add(&bar[XB_XSUB(b.x)], 1u);
        const unsigned gen = old / nloc;
        if (old + 1u == (gen + 1u) * nloc) {
            __builtin_amdgcn_fence(__ATOMIC_RELEASE, "agent");
            asm volatile("s_waitcnt vmcnt(0)" ::: "memory");
            const unsigned og = xb_add(&bar[XB_TOP], 1u);
            const unsigned tg = og / nx;
            if (og + 1u == (tg + 1u) * nx) xb_add(&bar[XB_TOPGEN], 1u);
            else XB_SPIN(xb_ld(&bar[XB_TOPGEN]) == tg, bar);
            __builtin_amdgcn_fence(__ATOMIC_ACQUIRE, "agent");
            xb_add(&bar[XB_XGEN(b.x)], 1u);
            asm volatile("s_waitcnt vmcnt(0)" ::: "memory");
        } else {
            XB_SPIN(xb_ld(&bar[XB_XGEN(b.x)]) == gen, bar);
            __builtin_amdgcn_fence(__ATOMIC_ACQUIRE, "agent");
            asm volatile("s_waitcnt vmcnt(0)" ::: "memory");
        }
    }
    __syncthreads();
}

#ifdef REP_SYNC
#define SYNC_IF(ph) if ((ph) + 1 < p.ph_end) { xcd_barrier(xb); xcd_barrier(xb); }
#else
#define SYNC_IF(ph) if ((ph) + 1 < p.ph_end) { xcd_barrier(xb); }
#endif
#define RUNPH(ph, stmt) if (p.ph_begin <= (ph) && (ph) < p.ph_end) { stmt; SYNC_IF(ph) }
template <int L>
__device__ __forceinline__ void run_layer(const Params& p, char* lds, cg::grid_group& grid, const XcdBarrier& xb) {
#ifdef REP_INPROJ
    RUNPH(1 + 8 * L + 0, ({ phase_inproj(p, L, lds); xcd_barrier(xb); phase_inproj(p, L, lds); }))
#else
    RUNPH(1 + 8 * L + 0, phase_inproj(p, L, lds))
#endif
#ifdef REP_SMALL
    RUNPH(1 + 8 * L + 1, ({ phase_small(p, L, lds); xcd_barrier(xb); phase_small(p, L, lds); }))
#else
    RUNPH(1 + 8 * L + 1, phase_small(p, L, lds))
#endif
#ifdef REP_ATTN
    RUNPH(1 + 8 * L + 2, ({ phase_attn(p, L, lds, 32); xcd_barrier(xb); phase_attn(p, L, lds); }))
#else
    RUNPH(1 + 8 * L + 2, phase_attn(p, L, lds))
#endif
    RUNPH(1 + 8 * L + 3, phase_resgemm(p, ((bf16_t*)(p.ws + OFF_MIXB)), DM, ((bf16_t*)(p.ws + OFF_WT_O)) + (size_t)L * DM * DM, DM, lds, L ? p.ln2_g + (L - 1) * DM : nullptr, L ? p.ln2_b + (L - 1) * DM : nullptr, L ? (const float*)p.out : p.x))
    RUNPH(1 + 8 * L + 4, phase_ln<false>(p, p.ln1_g + L * DM, p.ln1_b + L * DM))
#ifndef SKIP_UP
#ifdef REP_UP
    RUNPH(1 + 8 * L + 5, ({ phase_up(p, L, lds); xcd_barrier(xb); phase_up(p, L, lds); }))
#else
    RUNPH(1 + 8 * L + 5, phase_up(p, L, lds))
#endif
#else
    RUNPH(1 + 8 * L + 5, (void)0)
#endif
#ifdef DUMP_ACT
    RUNPH(1 + 8 * L + 6, ({ const int tid_ = otid();
        for (int i = blockIdx.x * 512 + tid_; i < T_ * DM; i += gridDim.x * 512) { const int tok = i >> 10, c = i & 1023;
            const float v_ = bf2f(((bf16_t*)(p.ws + DUMP_OFF))[(size_t)tok * DUMP_PITCH + c]); p.out[i] = (fabsf(v_) <= 3.0e38f) ? 0.f : 1000.f; } }))
#else
    RUNPH(1 + 8 * L + 6, phase_resgemm(p, ((bf16_t*)(p.ws + OFF_H)), DFFP, ((bf16_t*)(p.ws + OFF_WT_DN)) + (size_t)L * DM * DFFP, DFFP, lds, p.ln1_g + L * DM, p.ln1_b + L * DM, (const float*)p.out))
#endif
    RUNPH(1 + 8 * L + 7, phase_ln<(L == 3)>(p, p.ln2_g + L * DM, p.ln2_b + L * DM))
}

__global__ void __launch_bounds__(512) mega(Params p) {
    extern __shared__ __attribute__((aligned(16))) char lds[];
    cg::grid_group grid = cg::this_grid();
    volatile LDSAS unsigned* st_ = (volatile LDSAS unsigned*)(lds + 147456);
    if (threadIdx.x == 0) { st_[0] = 0u; st_[1] = 0u; }
    __syncthreads();
    const XcdBarrier xb = xcd_barrier_post((unsigned*)(p.ws + OFF_BAR), st_);
    grid.sync();
#ifdef REP_PRO
    RUNPH(0, ({ phase_prologue(p, lds); xcd_barrier(xb); phase_prologue(p, lds); }))
#else
    RUNPH(0, phase_prologue(p, lds))
#endif
    run_layer<0>(p, lds, grid, xb);
    run_layer<1>(p, lds, grid, xb);
    run_layer<2>(p, lds, grid, xb);
    run_layer<3>(p, lds, grid, xb);
}

extern "C" void kernel_launch(void* const* d_in, const int* in_sizes, int n_in, void* d_out, int out_size, void* d_ws, size_t ws_size, hipStream_t stream) {
    static int grid_blocks = 0;
    if (!grid_blocks) {
        int dev = 0, cus = 0, per_cu = 0;
        hipGetDevice(&dev);
        hipFuncSetAttribute((const void*)mega, hipFuncAttributeMaxDynamicSharedMemorySize, LDS_BYTES);
        hipDeviceGetAttribute(&cus, hipDeviceAttributeMultiprocessorCount, dev);
        hipOccupancyMaxActiveBlocksPerMultiprocessor(&per_cu, mega, 512, LDS_BYTES);
        if (per_cu < 1) per_cu = 1;
        grid_blocks = cus * 1;
        if (grid_blocks > 256) grid_blocks = 256;
        grid_blocks &= ~7;
    }
    Params p{};
    const float* const* in = (const float* const*)d_in;
    p.x = in[0]; p.w_in = in[1]; p.b_forget = in[2]; p.diff_lambda = in[3]; p.diff_subln = in[4]; p.mla_q_norm = in[5]; p.mla_kv_norm = in[6];
    p.mla_w_uq = in[7]; p.mla_w_ukv = in[8]; p.rel_bias = in[9]; p.w_o = in[10]; p.ln1_g = in[11]; p.ln1_b = in[12]; p.w_up = in[13];
    p.conv_w = in[14]; p.conv_b = in[15]; p.w_down = in[16]; p.ln2_g = in[17]; p.ln2_b = in[18];
    p.out = (float*)d_out;
    p.ws = (char*)d_ws; const size_t off = WS_NEEDED;
    hipMemsetAsync((char*)d_ws + OFF_BAR, 0, XCD_BAR_WORDS * 4, stream);
    for (int l = 0; l < 4; ++l) p.lam_init[l] = (float)(0.8 - 0.6 * exp(-0.3 * (double)l));
    if (off > ws_size) fprintf(stderr, "workspace too small: need %zu have %zu\n", off, ws_size);
#if N_LAUNCH_SPLIT
    for (int ph = 0; ph < 33; ++ph) {
        p.ph_begin = ph; p.ph_end = ph + 1;
        void* args[] = {&p};
        hipError_t e = hipLaunchCooperativeKernel((void*)mega, dim3(grid_blocks), dim3(512), args, LDS_BYTES, stream);
        if (e != hipSuccess) fprintf(stderr, "launch failed: %s\n", hipGetErrorString(e));
    }
#else
#ifndef PH_END
#define PH_END 33
#endif
    p.ph_begin = 0; p.ph_end = PH_END;
    void* args[] = {&p};
    hipError_t e = hipLaunchCooperativeKernel((void*)mega, dim3(grid_blocks), dim3(512), args, LDS_BYTES, stream);
    if (e != hipSuccess) fprintf(stderr, "cooperative launch failed: %s (grid %d)\n", hipGetErrorString(e), grid_blocks);
#endif
}
```

```cpp
#include <hip/hip_runtime.h>
#include <hip/hip_cooperative_groups.h>
#include <stdint.h>
#include <stdio.h>
namespace cg = cooperative_groups;

typedef unsigned short bf16_t;
typedef short bf16x8 __attribute__((ext_vector_type(8)));
typedef short s16x4 __attribute__((ext_vector_type(4)));
typedef short v4i16_t __attribute__((ext_vector_type(4)));
typedef float f32x16 __attribute__((ext_vector_type(16)));
typedef float f32x4 __attribute__((ext_vector_type(4)));
typedef unsigned u32x4 __attribute__((ext_vector_type(4)));
typedef unsigned u32x2 __attribute__((ext_vector_type(2)));
#define LDSAS __attribute__((address_space(3)))

#ifndef N_LAUNCH_SPLIT
#define N_LAUNCH_SPLIT 0
#endif
#ifdef DIAG
#define PH_END 8
#define DUMP_ACT 0
#define UP_PLAIN 1
#define UP_ALIGNED 1
#define DUMP_OFF OFF_H
#define DUMP_PITCH DFFP
#endif

constexpr int T_ = 16384, S_ = 8192, DM = 1024, NIN = 2724, NINP = 2816, DFF = 2752, DFFP = 2816, NUP = 5632, NUPSRC = 5504;
constexpr int XB_ROWS = T_ + 256;
constexpr float LOG2E = 1.4426950408889634f;
constexpr float ALPHA = 1.681792830507429f;
constexpr int LDS_BYTES = 147456 + 16;
constexpr int GEMM_STAGE = 73728, GEMM_BOFF = 36864, GEMM_RS = 144;
constexpr int U_RS = 520;

constexpr size_t al256(size_t x) { return (x + 255) & ~(size_t)255; }
constexpr size_t OFF_WT_IN = 0;
constexpr size_t OFF_WT_O = OFF_WT_IN + al256((size_t)4 * NINP * DM * 2);
constexpr size_t OFF_WT_UP = OFF_WT_O + al256((size_t)4 * DM * DM * 2);
constexpr size_t OFF_WT_DN = OFF_WT_UP + al256((size_t)4 * NUP * DM * 2);
constexpr size_t OFF_WT_UQ = OFF_WT_DN + al256((size_t)4 * DM * DFFP * 2);
constexpr size_t OFF_WT_UKV = OFF_WT_UQ + al256((size_t)4 * 384 * 256 * 2);
constexpr size_t OFF_XB = OFF_WT_UKV + al256((size_t)4 * 512 * 128 * 2);
constexpr size_t OFF_H = OFF_XB + al256((size_t)XB_ROWS * DM * 2);
constexpr size_t OFF_LQ = OFF_H + al256((size_t)T_ * NINP * 2);
constexpr size_t OFF_LK = OFF_LQ + al256((size_t)T_ * 384 * 2);
constexpr size_t OFF_LV = OFF_LK + al256((size_t)T_ * 384 * 2);
constexpr size_t OFF_MIXB = OFF_LV + al256((size_t)T_ * 256 * 2);
constexpr size_t OFF_KMHI = OFF_MIXB + al256((size_t)T_ * DM * 2);
constexpr size_t OFF_KMLO = OFF_KMHI + al256((size_t)8 * 32 * 64 * 2);
constexpr size_t OFF_LOGF = OFF_KMLO + al256((size_t)8 * 32 * 64 * 2);
constexpr size_t OFF_NEGC = OFF_LOGF + al256((size_t)T_ * 4 * 4);
constexpr size_t OFF_ROPEC = OFF_NEGC + al256((size_t)8 * S_ * 4);
constexpr size_t OFF_ROPES = OFF_ROPEC + al256((size_t)S_ * 16 * 4);
constexpr size_t OFF_BUCKET = OFF_ROPES + al256((size_t)S_ * 16 * 4);
constexpr size_t OFF_COUNTERS = OFF_BUCKET + al256(128 * 4);
constexpr size_t OFF_NORMS = OFF_COUNTERS + al256(64 * 4);
constexpr size_t OFF_STATS = OFF_NORMS + al256(512 * 4);
constexpr size_t OFF_BAR = OFF_STATS + al256((size_t)T_ * 2 * 4);
constexpr size_t WS_NEEDED = OFF_BAR + al256(3456 * 4);

struct Params {
    const float *x, *w_in, *b_forget, *diff_lambda, *diff_subln, *mla_q_norm, *mla_kv_norm, *mla_w_uq, *mla_w_ukv, *rel_bias, *w_o,
        *ln1_g, *ln1_b, *w_up, *conv_w, *conv_b, *w_down, *ln2_g, *ln2_b;
    float* out;
    char* ws;
    float lam_init[4];
    int ph_begin, ph_end;
};

#define MFMA32(a, b, c) __builtin_amdgcn_mfma_f32_32x32x16_bf16(a, b, c, 0, 0, 0)
__device__ __forceinline__ int crow(int r, int hi) { return (r & 3) + 8 * (r >> 2) + 4 * hi; }
typedef float f32x2_ __attribute__((ext_vector_type(2)));
typedef __bf16 bf16v2_ __attribute__((ext_vector_type(2)));
__device__ __forceinline__ unsigned cvtpk(float lo, float hi) { f32x2_ v = {lo, hi}; bf16v2_ b = __builtin_convertvector(v, bf16v2_); return __builtin_bit_cast(unsigned, b); }
__device__ __forceinline__ bf16_t f2bf(float f) { return (bf16_t)(cvtpk(f, 0.f) & 0xffffu); }
__device__ __forceinline__ float bf2f(bf16_t b) { return __uint_as_float(((unsigned)b) << 16); }
__device__ __forceinline__ float bfs2f(short b) { return __uint_as_float(((unsigned)(unsigned short)b) << 16); }
__device__ __forceinline__ s16x4 vtr(const LDSAS char* p) { return __builtin_bit_cast(s16x4, __builtin_amdgcn_ds_read_tr16_b64_v4i16((LDSAS v4i16_t*)p)); }
__device__ __forceinline__ float swapmax(float v) { auto rr = __builtin_amdgcn_permlane32_swap(__float_as_uint(v), __float_as_uint(v), false, false); return fmaxf(__uint_as_float(rr[0]), __uint_as_float(rr[1])); }
__device__ __forceinline__ float swapsum(float v) { auto rr = __builtin_amdgcn_permlane32_swap(__float_as_uint(v), __float_as_uint(v), false, false); return __uint_as_float(rr[0]) + __uint_as_float(rr[1]); }
__device__ __forceinline__ float fexp2(float x) { return __builtin_amdgcn_exp2f(x); }
__device__ __forceinline__ int otid() { int t = threadIdx.x; asm volatile("" : "+v"(t)); return t; }

__device__ __forceinline__ int src_col(int type, int n, float& sc) {
    sc = 1.f;
    if (type == 0) {
        if (n < 256) sc = 0.125f * LOG2E;
        else if (n >= 768 && n < 1024) sc = 0.17677669529663687f * LOG2E;
        else if (n >= 1536 && n < 1792) sc = 0.125f * LOG2E;
        if (n < 768) return n;
        if (n < 2720) return n + 4;
        if (n < 2724) return 768 + (n - 2720);
        return -1;
    } else if (type == 2) {
        const int pn = n >> 8, j = n & 255;
        const int c = pn * 128 + (j & 127);
        if (c >= DFF) return -1;
        return (j < 128) ? c : DFF + c;
    } else if (type == 4) {
        sc = 0.10206207261596575f * LOG2E;
        return n;
    }
    return n;
}

__device__ __forceinline__ void transpose_tile(const float* __restrict__ W, int K, int N, bf16_t* __restrict__ Wt, int Kp, int n0, int k0, int type, char* lds, const float* __restrict__ gk = nullptr) {
    const int tid = otid();
    unsigned* tl = (unsigned*)lds;
    {
        const int g = tid & 15; float sc; const int src = src_col(type, n0 + 4 * g, sc);
#pragma unroll
        for (int i = 0; i < 2; ++i) {
            const int kk = (tid >> 4) + 32 * i, k = k0 + kk;
            f32x4 v = {0.f, 0.f, 0.f, 0.f};
            if (src >= 0 && k < K) v = *(const f32x4*)(W + (size_t)k * N + src);
            const float sck = (gk && k < K) ? sc * gk[k] : sc;
            tl[kk * 33 + 2 * g] = cvtpk(v[0] * sck, v[1] * sck);
            tl[kk * 33 + 2 * g + 1] = cvtpk(v[2] * sck, v[3] * sck);
        }
    }
    __syncthreads();
    {
        const int nn = tid >> 3, c = tid & 7;
        const unsigned short* t16 = (const unsigned short*)lds;
        unsigned w[4];
#pragma unroll
        for (int j = 0; j < 4; ++j) {
            const unsigned lo = t16[(c * 8 + 2 * j) * 66 + nn], hi_ = t16[(c * 8 + 2 * j + 1) * 66 + nn];
            w[j] = lo | (hi_ << 16);
        }
        *(u32x4*)(Wt + (size_t)(n0 + nn) * Kp + k0 + c * 8) = (u32x4){w[0], w[1], w[2], w[3]};
    }
    __syncthreads();
}

__device__ __forceinline__ void convert_tile(const Params& p, int l, int r, char* lds) {
        if (r < 704) { const int nt = r / 16, kt = r % 16; transpose_tile(p.w_in + (size_t)l * DM * NIN, DM, NIN, ((bf16_t*)(p.ws + OFF_WT_IN)) + (size_t)l * NINP * DM, DM, nt * 64, kt * 64, 0, lds); return; }
        r -= 704;
        if (r < 256) { const int nt = r / 16, kt = r % 16; transpose_tile(p.w_o + (size_t)l * DM * DM, DM, DM, ((bf16_t*)(p.ws + OFF_WT_O)) + (size_t)l * DM * DM, DM, nt * 64, kt * 64, 1, lds); return; }
        r -= 256;
        if (r < 1408) { const int nt = r / 16, kt = r % 16; transpose_tile(p.w_up + (size_t)l * DM * NUPSRC, DM, NUPSRC, ((bf16_t*)(p.ws + OFF_WT_UP)) + (size_t)l * NUP * DM, DM, nt * 64, kt * 64, 2, lds); return; }
        r -= 1408;
        if (r < 704) { const int nt = r / 44, kt = r % 44; transpose_tile(p.w_down + (size_t)l * DFF * DM, DFF, DM, ((bf16_t*)(p.ws + OFF_WT_DN)) + (size_t)l * DM * DFFP, DFFP, nt * 64, kt * 64, 3, lds); return; }
        r -= 704;
        if (r < 24) { const int nt = r / 4, kt = r % 4; transpose_tile(p.mla_w_uq + (size_t)l * 256 * 384, 256, 384, ((bf16_t*)(p.ws + OFF_WT_UQ)) + (size_t)l * 384 * 256, 256, nt * 64, kt * 64, 4, lds, p.mla_q_norm + l * 256); return; }
        r -= 24;
        { const int nt = r / 2, kt = r % 2; transpose_tile(p.mla_w_ukv + (size_t)l * 128 * 512, 128, 512, ((bf16_t*)(p.ws + OFF_WT_UKV)) + (size_t)l * 512 * 128, 128, nt * 64, kt * 64, 5, lds, p.mla_kv_norm + l * 128); }
}

__device__ __forceinline__ void phase_prologue(const Params& p, char* lds) {
    const int tid = otid(), nb = gridDim.x, bid = blockIdx.x;
    for (int t = bid; t < 3112; t += nb) convert_tile(p, 0, t, lds);
    const size_t gtid = (size_t)bid * 512 + tid, gn = (size_t)nb * 512;
    for (size_t i = gtid; i < (size_t)T_ * DM / 8; i += gn) {
        const f32x4 a = *(const f32x4*)(p.x + i * 8), b = *(const f32x4*)(p.x + i * 8 + 4);
        u32x4 w; w.x = cvtpk(a[0], a[1]); w.y = cvtpk(a[2], a[3]); w.z = cvtpk(b[0], b[1]); w.w = cvtpk(b[2], b[3]);
        *(u32x4*)(((bf16_t*)(p.ws + OFF_XB)) + i * 8) = w;
    }
    for (size_t i = gtid; i < (size_t)256 * DM / 8; i += gn) *(u32x4*)(((bf16_t*)(p.ws + OFF_XB)) + (size_t)T_ * DM + i * 8) = (u32x4){0u, 0u, 0u, 0u};
    for (size_t i = gtid; i < (size_t)S_ * 16; i += gn) {
        const int pos = (int)(i >> 4), j = (int)(i & 15);
        const float inv = exp2f(-(float)j * (2.0f / 32.0f) * 13.287712379549449f);
        const float ang = (float)pos * inv;
        const double rev = (double)ang * 0.15915494309189535;
        const double fr = rev - floor(rev);
        const float a2 = (float)(fr * 6.283185307179586);
        ((float*)(p.ws + OFF_ROPEC))[i] = cosf(a2); ((float*)(p.ws + OFF_ROPES))[i] = sinf(a2);
    }
    if (bid == 0) {
        if (tid < 128) {
            int b;
            if (tid < 16) b = tid;
            else { const float v = logf((float)tid / 16.0f) / 2.0794415416798357f * 16.0f; b = 16 + (int)v; if (b > 31) b = 31; }
            ((int*)(p.ws + OFF_BUCKET))[tid] = b;
        }
        if (tid < 64) ((unsigned*)(p.ws + OFF_COUNTERS))[tid] = 0u;
    }
}

__device__ __forceinline__ void tile_map(int t, int nM, int nN, int& pm, int& pn) {
    const int nwg = nM * nN;
    const int q = nwg / 8, r = nwg % 8, xcd = t % 8, off = t / 8;
    const int wgid = (xcd < r ? xcd * (q + 1) : r * (q + 1) + (xcd - r) * q) + off;
    const int nig = 8 * nN, gid = wgid / nig, fm = gid * 8, gsz = (nM - fm) < 8 ? (nM - fm) : 8;
    pm = fm + ((wgid % nig) % gsz); pn = (wgid % nig) / gsz;
}

__device__ __forceinline__ void gemm_tile(const bf16_t* __restrict__ A, int lda, const bf16_t* __restrict__ B, int ldb, int K, char* lds, f32x16 (&acc)[4][2]) {
    const int tid = otid(), lane = tid & 63, r32 = lane & 31, hi = lane >> 5, wid = __builtin_amdgcn_readfirstlane(tid >> 6), wr = wid >> 2, wc = wid & 3;
#pragma unroll
    for (int mt = 0; mt < 4; ++mt)
#pragma unroll
        for (int nt = 0; nt < 2; ++nt)
#pragma unroll
            for (int r = 0; r < 16; ++r) acc[mt][nt][r] = 0.f;
    const bf16_t* ga = A + (size_t)(tid >> 3) * lda + (tid & 7) * 8;
    const bf16_t* gb = B + (size_t)(tid >> 3) * ldb + (tid & 7) * 8;
    const int lw = (tid >> 3) * GEMM_RS + (tid & 7) * 16;
    u32x4 ra[4], rb[4];
    const int nkt = K / 64;
#pragma unroll
    for (int i = 0; i < 4; ++i) { ra[i] = *(const u32x4*)(ga + (size_t)i * 64 * lda); rb[i] = *(const u32x4*)(gb + (size_t)i * 64 * ldb); }
#pragma unroll
    for (int i = 0; i < 4; ++i) { *(u32x4*)(lds + lw + i * 64 * GEMM_RS) = ra[i]; *(u32x4*)(lds + GEMM_BOFF + lw + i * 64 * GEMM_RS) = rb[i]; }
#pragma unroll
    for (int i = 0; i < 4; ++i) { ra[i] = *(const u32x4*)(ga + (size_t)i * 64 * lda + 64); rb[i] = *(const u32x4*)(gb + (size_t)i * 64 * ldb + 64); }
    __syncthreads();
    const int la0 = (wr * 128 + r32) * GEMM_RS + hi * 16, lb0 = GEMM_BOFF + (wc * 64 + r32) * GEMM_RS + hi * 16;
    for (int kt = 0; kt < nkt; ++kt) {
        const int buf = kt & 1;
        if (kt + 1 < nkt) {
            char* nbase = lds + (buf ^ 1) * GEMM_STAGE;
#pragma unroll
            for (int i = 0; i < 4; ++i) { *(u32x4*)(nbase + lw + i * 64 * GEMM_RS) = ra[i]; *(u32x4*)(nbase + GEMM_BOFF + lw + i * 64 * GEMM_RS) = rb[i]; }
        }
        if (kt + 2 < nkt) {
#pragma unroll
            for (int i = 0; i < 4; ++i) { ra[i] = *(const u32x4*)(ga + (size_t)i * 64 * lda + (kt + 2) * 64); rb[i] = *(const u32x4*)(gb + (size_t)i * 64 * ldb + (kt + 2) * 64); }
        }
        __builtin_amdgcn_sched_barrier(0);
        const char* base = lds + buf * GEMM_STAGE;
#pragma unroll
        for (int kk = 0; kk < 4; ++kk) {
            bf16x8 af[4], bfr[2];
#pragma unroll
            for (int mt = 0; mt < 4; ++mt) af[mt] = *(const bf16x8*)(base + la0 + mt * 32 * GEMM_RS + kk * 32);
#pragma unroll
            for (int nt = 0; nt < 2; ++nt) bfr[nt] = *(const bf16x8*)(base + lb0 + nt * 32 * GEMM_RS + kk * 32);
#pragma unroll
            for (int mt = 0; mt < 4; ++mt)
#pragma unroll
                for (int nt = 0; nt < 2; ++nt) acc[mt][nt] = MFMA32(bfr[nt], af[mt], acc[mt][nt]);
        }
        __syncthreads();
    }
}

__device__ __forceinline__ void stage_acc(const f32x16 (&acc)[4][2], char* lds) {
    const int tid = otid(), lane = tid & 63, r32 = lane & 31, hi = lane >> 5, wid = __builtin_amdgcn_readfirstlane(tid >> 6), wr = wid >> 2, wc = wid & 3;
#pragma unroll
    for (int mt = 0; mt < 4; ++mt)
#pragma unroll
        for (int nt = 0; nt < 2; ++nt)
#pragma unroll
            for (int g = 0; g < 4; ++g) {
                const int t = wr * 128 + mt * 32 + r32, n = wc * 64 + nt * 32 + 8 * g + 4 * hi;
                u32x2 w; w.x = cvtpk(acc[mt][nt][4 * g], acc[mt][nt][4 * g + 1]); w.y = cvtpk(acc[mt][nt][4 * g + 2], acc[mt][nt][4 * g + 3]);
                *(u32x2*)(lds + t * U_RS + n * 2) = w;
            }
    __syncthreads();
}

__device__ __forceinline__ void phase_inproj(const Params& p, int l, char* lds) {
    const int tid = otid(), lane = tid & 63, r32 = lane & 31, hi = lane >> 5, wid = __builtin_amdgcn_readfirstlane(tid >> 6), wr = wid >> 2, wc = wid & 3;
    const bf16_t* Wt = ((bf16_t*)(p.ws + OFF_WT_IN)) + (size_t)l * NINP * DM;
    for (int t = blockIdx.x; t < 64 * 11; t += gridDim.x) {
        int pm, pn; tile_map(t, 64, 11, pm, pn);
        f32x16 acc[4][2];
        gemm_tile(((bf16_t*)(p.ws + OFF_XB)) + (size_t)pm * 256 * DM, DM, Wt + (size_t)pn * 256 * DM, DM, DM, lds, acc);
        if (pn == 10 && wc == 2 && hi == 0) {
            const f32x4 bfv = *(const f32x4*)(p.b_forget + l * 4);
#pragma unroll
            for (int mt = 0; mt < 4; ++mt) {
                const int tok = pm * 256 + wr * 128 + mt * 32 + r32;
                f32x4 o;
#pragma unroll
                for (int j = 0; j < 4; ++j) { const float xv = acc[mt][1][j] + bfv[j]; o[j] = fminf(xv, 0.f) - log1pf(expf(-fabsf(xv))); }
                *(f32x4*)(((float*)(p.ws + OFF_LOGF)) + (size_t)tok * 4) = o;
            }
        }
        stage_acc(acc, lds);
#pragma unroll 4
        for (int i = 0; i < 32; ++i) {
            const int tl = wid + 8 * i;
            const u32x2 v = *(const u32x2*)(lds + tl * U_RS + lane * 8);
            *(u32x2*)(((bf16_t*)(p.ws + OFF_H)) + (size_t)(pm * 256 + tl) * NINP + pn * 256 + lane * 4) = v;
        }
        float* red = (float*)(lds + 135168);
        const int bq = pm >> 5, blk = pm & 31;
        if (pn == 7) {
            const int col = tid & 255, half = tid >> 8;
            float sum = 0.f;
#pragma unroll 8
            for (int r = 0; r < 128; ++r) sum += bf2f(*(const bf16_t*)(lds + (half * 128 + r) * U_RS + col * 2));
            red[half * 256 + col] = sum;
            __syncthreads();
            if (tid < 256) {
                const float mean = (red[tid] + red[256 + tid]) * (1.0f / 256.0f);
                const int hd = tid >> 6, d = tid & 63;
                const bf16_t hb = f2bf(mean);
                ((bf16_t*)(p.ws + OFF_KMHI))[(((size_t)(bq * 4 + hd)) * 32 + blk) * 64 + d] = hb;
                ((bf16_t*)(p.ws + OFF_KMLO))[(((size_t)(bq * 4 + hd)) * 32 + blk) * 64 + d] = f2bf(mean - bf2f(hb));
            }
        } else if (pn <= 1) {
            const int row = tid & 255, hp = tid >> 8;
            float n0_ = 0.f, n1_ = 0.f;
#pragma unroll 4
            for (int c = 0; c < 16; ++c) {
                const u32x2 a = *(const u32x2*)(lds + row * U_RS + (hp * 128) * 2 + c * 8), b_ = *(const u32x2*)(lds + row * U_RS + (hp * 128 + 64) * 2 + c * 8);
                const float a0 = __uint_as_float(a.x << 16), a1 = __uint_as_float(a.x & 0xffff0000u), a2 = __uint_as_float(a.y << 16), a3 = __uint_as_float(a.y & 0xffff0000u);
                const float b0 = __uint_as_float(b_.x << 16), b1 = __uint_as_float(b_.x & 0xffff0000u), b2 = __uint_as_float(b_.y << 16), b3 = __uint_as_float(b_.y & 0xffff0000u);
                n0_ += a0 * a0 + a1 * a1 + a2 * a2 + a3 * a3; n1_ += b0 * b0 + b1 * b1 + b2 * b2 + b3 * b3;
            }
#pragma unroll
            for (int o_ = 32; o_ >= 1; o_ >>= 1) { n0_ = fmaxf(n0_, __shfl_xor(n0_, o_)); n1_ = fmaxf(n1_, __shfl_xor(n1_, o_)); }
            if (lane == 0) { red[wid * 2] = n0_; red[wid * 2 + 1] = n1_; }
            __syncthreads();
            if (tid < 4) {
                const int hpw = tid >> 1, which = tid & 1;
                float m_ = 0.f;
                for (int w = 0; w < 4; ++w) m_ = fmaxf(m_, red[(hpw * 4 + w) * 2 + which]);
                ((float*)(p.ws + OFF_NORMS))[pn * 256 + (bq * 4 + tid) * 32 + blk] = m_;
            }
        }
        __syncthreads();
    }
}

__device__ __forceinline__ void phase_resgemm(const Params& p, const bf16_t* A, int lda, const bf16_t* Wt, int K, char* lds, const float* __restrict__ rg, const float* __restrict__ rb, const float* __restrict__ rsrc) {
    const int tid = otid(), lane = tid & 63, r32 = lane & 31, hi = lane >> 5, wid = __builtin_amdgcn_readfirstlane(tid >> 6), wr = wid >> 2, wc = wid & 3;
    constexpr int RS = 260;
    float* stg = (float*)lds;
    for (int t = blockIdx.x; t < 64 * 4; t += gridDim.x) {
        int pm, pn; tile_map(t, 64, 4, pm, pn);
        f32x16 acc[4][2];
        gemm_tile(A + (size_t)pm * 256 * lda, lda, Wt + (size_t)pn * 256 * K, K, K, lds, acc);
        f32x4 gr = {1.f, 1.f, 1.f, 1.f}, br = {0.f, 0.f, 0.f, 0.f};
        if (rg) { gr = *(const f32x4*)(rg + pn * 256 + lane * 4); br = *(const f32x4*)(rb + pn * 256 + lane * 4); }
#pragma unroll
        for (int mt = 0; mt < 4; ++mt) {
#pragma unroll
            for (int nt = 0; nt < 2; ++nt)
#pragma unroll
                for (int g = 0; g < 4; ++g) {
                    f32x4 v = {acc[mt][nt][4 * g], acc[mt][nt][4 * g + 1], acc[mt][nt][4 * g + 2], acc[mt][nt][4 * g + 3]};
                    *(f32x4*)(stg + (wr * 32 + r32) * RS + wc * 64 + nt * 32 + 8 * g + 4 * hi) = v;
                }
            __syncthreads();
#pragma unroll
            for (int i = 0; i < 8; ++i) {
                const int lr = wid * 8 + i;
                const int tok = pm * 256 + (lr >> 5) * 128 + mt * 32 + (lr & 31);
                float* px = p.out + (size_t)tok * DM + pn * 256 + lane * 4;
                f32x4 xv = *(const f32x4*)(rsrc + (size_t)tok * DM + pn * 256 + lane * 4);
                const f32x4 av = *(const f32x4*)(stg + lr * RS + lane * 4);
                float mu = 0.f, rstd = 1.f;
                if (rg) { const float* st = ((const float*)(p.ws + OFF_STATS)) + (size_t)tok * 2; mu = st[0]; rstd = st[1]; }
#pragma unroll
                for (int j = 0; j < 4; ++j) xv[j] = ALPHA * ((xv[j] - mu) * rstd * gr[j] + br[j]) + av[j];
                *(f32x4*)px = xv;
            }
            __syncthreads();
        }
    }
}

template <bool WRITE_OUT>
__device__ __forceinline__ void phase_ln(const Params& p, const float* __restrict__ g, const float* __restrict__ b) {
    const int tid = otid(), lane = tid & 63, wid = __builtin_amdgcn_readfirstlane(tid >> 6);
    f32x4 gv[4], bv[4];
#pragma unroll
    for (int i = 0; i < 4; ++i) { gv[i] = *(const f32x4*)(g + i * 256 + lane * 4); bv[i] = *(const f32x4*)(b + i * 256 + lane * 4); }
    for (int row = blockIdx.x * 8 + wid; row < T_; row += gridDim.x * 8) {
        float* pr = p.out + (size_t)row * DM;
        f32x4 v[4]; float s = 0.f;
#pragma unroll
        for (int i = 0; i < 4; ++i) { v[i] = *(const f32x4*)(pr + i * 256 + lane * 4); s += (v[i][0] + v[i][1]) + (v[i][2] + v[i][3]); }
#pragma unroll
        for (int o = 32; o >= 1; o >>= 1) s += __shfl_xor(s, o);
        const float mu = s * (1.0f / 1024.0f);
        float q = 0.f;
#pragma unroll
        for (int i = 0; i < 4; ++i)
#pragma unroll
            for (int j = 0; j < 4; ++j) { const float d = v[i][j] - mu; q += d * d; }
#pragma unroll
        for (int o = 32; o >= 1; o >>= 1) q += __shfl_xor(q, o);
        const float rstd = rsqrtf(q * (1.0f / 1024.0f) + 1e-5f);
        if (!WRITE_OUT && lane == 0) { float* st = ((float*)(p.ws + OFF_STATS)) + (size_t)row * 2; st[0] = mu; st[1] = rstd; }
#pragma unroll
        for (int i = 0; i < 4; ++i) {
            f32x4 y;
#pragma unroll
            for (int j = 0; j < 4; ++j) y[j] = (v[i][j] - mu) * rstd * gv[i][j] + bv[i][j];
            if (WRITE_OUT) *(f32x4*)(pr + i * 256 + lane * 4) = y;
            u32x2 w; w.x = cvtpk(y[0], y[1]); w.y = cvtpk(y[2], y[3]);
            *(u32x2*)(((bf16_t*)(p.ws + OFF_XB)) + (size_t)row * DM + i * 256 + lane * 4) = w;
        }
    }
}

__device__ __forceinline__ void phase_up(const Params& p, int l, char* lds) {
    const int tid = otid();
    const bf16_t* Wt = ((bf16_t*)(p.ws + OFF_WT_UP)) + (size_t)l * NUP * DM;
    const float* cw = p.conv_w + (size_t)l * 3 * NUPSRC;
    const float* cb = p.conv_b + (size_t)l * NUPSRC;
    bf16_t* act = ((bf16_t*)(p.ws + OFF_H));
    for (int t = blockIdx.x; t < 66 * 22; t += gridDim.x) {
        int pm, pn; tile_map(t, 66, 22, pm, pn);
#ifdef UP_ALIGNED
        if (pm >= 64) continue;
        const int b = pm / 32, ii = pm % 32;
        const int r0 = pm * 256, lo = 0, bend = (b + 1) * S_;
#else
        const int b = pm / 33, ii = pm % 33;
        const int r0 = b * S_ + 254 * ii, lo = ii == 0 ? 0 : 2, bend = (b + 1) * S_;
#endif
        f32x16 acc[4][2];
        gemm_tile(((bf16_t*)(p.ws + OFF_XB)) + (size_t)r0 * DM, DM, Wt + (size_t)pn * 256 * DM, DM, DM, lds, acc);
        stage_acc(acc, lds);
        const int cg_ = tid & 31, ch = pn * 128 + 4 * cg_;
        const bool chv = ch < DFF;
        f32x4 wg[3], wv[3], bg, bvv;
        if (chv) {
#pragma unroll
            for (int j = 0; j < 3; ++j) { wg[j] = *(const f32x4*)(cw + j * NUPSRC + ch); wv[j] = *(const f32x4*)(cw + j * NUPSRC + DFF + ch); }
            bg = *(const f32x4*)(cb + ch); bvv = *(const f32x4*)(cb + DFF + ch);
        } else {
#pragma unroll
            for (int j = 0; j < 3; ++j) { wg[j] = (f32x4){0.f, 0.f, 0.f, 0.f}; wv[j] = wg[j]; }
            bg = (f32x4){0.f, 0.f, 0.f, 0.f}; bvv = bg;
        }
#pragma unroll 2
        for (int i = 0; i < 16; ++i) {
            const int tl = (tid >> 5) + 16 * i, tok = r0 + tl;
            if (tl >= lo && tok < bend) {
                f32x4 ag = bg, av = bvv;
#pragma unroll
                for (int j = 0; j < 3; ++j) {
                    const int ts = tl - 2 + j;
                    if (ts >= 0) {
                        const u32x2 ug = *(const u32x2*)(lds + ts * U_RS + cg_ * 8), uv = *(const u32x2*)(lds + ts * U_RS + 256 + cg_ * 8);
                        ag[0] += wg[j][0] * __uint_as_float(ug.x << 16); ag[1] += wg[j][1] * __uint_as_float(ug.x & 0xffff0000u);
                        ag[2] += wg[j][2] * __uint_as_float(ug.y << 16); ag[3] += wg[j][3] * __uint_as_float(ug.y & 0xffff0000u);
                        av[0] += wv[j][0] * __uint_as_float(uv.x << 16); av[1] += wv[j][1] * __uint_as_float(uv.x & 0xffff0000u);
                        av[2] += wv[j][2] * __uint_as_float(uv.y << 16); av[3] += wv[j][3] * __uint_as_float(uv.y & 0xffff0000u);
                    }
                }
                float o[4];
#ifdef UP_PLAIN
                { const u32x2 ug = *(const u32x2*)(lds + tl * U_RS + cg_ * 8); o[0] = __uint_as_float(ug.x << 16); o[1] = __uint_as_float(ug.x & 0xffff0000u); o[2] = __uint_as_float(ug.y << 16); o[3] = __uint_as_float(ug.y & 0xffff0000u); }
#else
#pragma unroll
                for (int j = 0; j < 4; ++j) { const float gte = ag[j]; o[j] = gte * __builtin_amdgcn_rcpf(1.f + __expf(-gte)) * av[j]; }
#endif
                u32x2 w; w.x = cvtpk(o[0], o[1]); w.y = cvtpk(o[2], o[3]);
                if (!chv) { w.x = 0u; w.y = 0u; }
                *(u32x2*)(act + (size_t)tok * DFFP + ch) = w;
            }
        }
        __syncthreads();
    }
}

__device__ __forceinline__ void store4(bf16_t* dst, const f32x16& c, int g) {
    u32x2 w; w.x = cvtpk(c[4 * g], c[4 * g + 1]); w.y = cvtpk(c[4 * g + 2], c[4 * g + 3]); *(u32x2*)dst = w;
}

__device__ __forceinline__ bf16x8 norm_frag(const bf16_t* src, const float* gn, float rstd) {
    const bf16x8 a = *(const bf16x8*)src;
    const f32x4 g0 = *(const f32x4*)gn, g1 = *(const f32x4*)(gn + 4);
    u32x4 w;
    w.x = cvtpk(bfs2f(a[0]) * rstd * g0[0], bfs2f(a[1]) * rstd * g0[1]); w.y = cvtpk(bfs2f(a[2]) * rstd * g0[2], bfs2f(a[3]) * rstd * g0[3]);
    w.z = cvtpk(bfs2f(a[4]) * rstd * g1[0], bfs2f(a[5]) * rstd * g1[1]); w.w = cvtpk(bfs2f(a[6]) * rstd * g1[2], bfs2f(a[7]) * rstd * g1[3]);
    return __builtin_bit_cast(bf16x8, w);
}

__device__ __forceinline__ void mla_stage2(const Params& p, int l, int task) {
    const int lane = otid() & 63, r32 = lane & 31, hi = lane >> 5;
    const int tt = task >> 2, part = task & 3;
    const int token = tt * 32 + r32, pos = token & (S_ - 1);
    const bf16_t* hrow = ((bf16_t*)(p.ws + OFF_H)) + (size_t)token * NINP;
    if (part < 2) {
        bf16x8 a[16]; float ss = 0.f;
#pragma unroll
        for (int kk = 0; kk < 16; ++kk) a[kk] = *(const bf16x8*)(hrow + 2304 + kk * 16 + hi * 8);
#pragma unroll
        for (int kk = 0; kk < 16; ++kk)
#pragma unroll
            for (int j = 0; j < 8; ++j) { const float f = bfs2f(a[kk][j]); ss += f * f; }
        ss = swapsum(ss);
        const float rstd = rsqrtf(ss * (1.0f / 256.0f) + 1e-6f);
        const bf16_t* W = ((bf16_t*)(p.ws + OFF_WT_UQ)) + (size_t)l * 384 * 256;
#pragma unroll 1
        for (int tg = 0; tg < 2; ++tg) {
            const int tile0 = part * 6 + tg * 3;
            f32x16 c[3];
#pragma unroll
            for (int q = 0; q < 3; ++q)
#pragma unroll
                for (int r = 0; r < 16; ++r) c[q][r] = 0.f;
#pragma unroll
            for (int kk = 0; kk < 16; ++kk) {
                if ((kk & 3) == 0) __builtin_amdgcn_sched_barrier(0);
#pragma unroll
                for (int q = 0; q < 3; ++q) {
                    const bf16x8 wf = *(const bf16x8*)(W + (size_t)((tile0 + q) * 32 + r32) * 256 + kk * 16 + hi * 8);
                    c[q] = MFMA32(wf, a[kk], c[q]);
                }
            }
#pragma unroll
            for (int q = 0; q < 3; ++q) {
#pragma unroll
                for (int r = 0; r < 16; ++r) c[q][r] *= rstd;
                const int tile = tile0 + q, head = tile / 3, sub = tile % 3;
                if (q == 2) {
                    const f32x4 c0 = *(const f32x4*)(((float*)(p.ws + OFF_ROPEC)) + pos * 16 + 4 * hi), c1 = *(const f32x4*)(((float*)(p.ws + OFF_ROPEC)) + pos * 16 + 8 + 4 * hi);
                    const f32x4 s0 = *(const f32x4*)(((float*)(p.ws + OFF_ROPES)) + pos * 16 + 4 * hi), s1 = *(const f32x4*)(((float*)(p.ws + OFF_ROPES)) + pos * 16 + 8 + 4 * hi);
#pragma unroll
                    for (int r = 0; r < 8; ++r) {
                        const float cs = r < 4 ? c0[r & 3] : c1[r & 3], sn = r < 4 ? s0[r & 3] : s1[r & 3];
                        const float t1 = c[q][r], t2 = c[q][r + 8];
                        c[q][r] = t1 * cs - t2 * sn; c[q][r + 8] = t2 * cs + t1 * sn;
                    }
                }
                bf16_t* dst = ((bf16_t*)(p.ws + OFF_LQ)) + (size_t)token * 384 + head * 96 + sub * 32 + 4 * hi;
#pragma unroll
                for (int g = 0; g < 4; ++g) store4(dst + 8 * g, c[q], g);
            }
        }
    } else {
        bf16x8 a[8]; float ss = 0.f;
#pragma unroll
        for (int kk = 0; kk < 8; ++kk) a[kk] = *(const bf16x8*)(hrow + 2560 + kk * 16 + hi * 8);
#pragma unroll
        for (int kk = 0; kk < 8; ++kk)
#pragma unroll
            for (int j = 0; j < 8; ++j) { const float f = bfs2f(a[kk][j]); ss += f * f; }
        ss = swapsum(ss);
        const float rstd = rsqrtf(ss * (1.0f / 128.0f) + 1e-6f);
        const bf16_t* W = ((bf16_t*)(p.ws + OFF_WT_UKV)) + (size_t)l * 512 * 128;
#pragma unroll 1
        for (int tg = 0; tg < 2; ++tg) {
            const int tile0 = (part - 2) * 8 + tg * 4;
            f32x16 c[4];
#pragma unroll
            for (int q = 0; q < 4; ++q)
#pragma unroll
                for (int r = 0; r < 16; ++r) c[q][r] = 0.f;
#pragma unroll
            for (int kk = 0; kk < 8; ++kk) {
                if ((kk & 1) == 0) __builtin_amdgcn_sched_barrier(0);
#pragma unroll
                for (int q = 0; q < 4; ++q) {
                    const bf16x8 wf = *(const bf16x8*)(W + (size_t)((tile0 + q) * 32 + r32) * 128 + kk * 16 + hi * 8);
                    c[q] = MFMA32(wf, a[kk], c[q]);
                }
            }
#pragma unroll
            for (int q = 0; q < 4; ++q) {
#pragma unroll
                for (int r = 0; r < 16; ++r) c[q][r] *= rstd;
                const int tile = tile0 + q, head = tile / 4, sub = q;
                bf16_t* dst = (sub < 2) ? (((bf16_t*)(p.ws + OFF_LK)) + (size_t)token * 384 + head * 96 + sub * 32 + 4 * hi) : (((bf16_t*)(p.ws + OFF_LV)) + (size_t)token * 256 + head * 64 + (sub - 2) * 32 + 4 * hi);
#pragma unroll
                for (int g = 0; g < 4; ++g) store4(dst + 8 * g, c[q], g);
            }
        }
        if (part == 3) {
            const bf16x8 x1 = *(const bf16x8*)(hrow + 2688 + hi * 8), x2 = *(const bf16x8*)(hrow + 2688 + 16 + hi * 8);
            const f32x4 c0 = *(const f32x4*)(((float*)(p.ws + OFF_ROPEC)) + pos * 16 + 8 * hi), c1 = *(const f32x4*)(((float*)(p.ws + OFF_ROPEC)) + pos * 16 + 8 * hi + 4);
            const f32x4 s0 = *(const f32x4*)(((float*)(p.ws + OFF_ROPES)) + pos * 16 + 8 * hi), s1 = *(const f32x4*)(((float*)(p.ws + OFF_ROPES)) + pos * 16 + 8 * hi + 4);
            float o1[8], o2[8];
#pragma unroll
            for (int j = 0; j < 8; ++j) {
                const float cs = j < 4 ? c0[j & 3] : c1[j & 3], sn = j < 4 ? s0[j & 3] : s1[j & 3];
                const float a1 = bfs2f(x1[j]), a2 = bfs2f(x2[j]);
                o1[j] = a1 * cs - a2 * sn; o2[j] = a2 * cs + a1 * sn;
            }
            u32x4 w1, w2;
            w1.x = cvtpk(o1[0], o1[1]); w1.y = cvtpk(o1[2], o1[3]); w1.z = cvtpk(o1[4], o1[5]); w1.w = cvtpk(o1[6], o1[7]);
            w2.x = cvtpk(o2[0], o2[1]); w2.y = cvtpk(o2[2], o2[3]); w2.z = cvtpk(o2[4], o2[5]); w2.w = cvtpk(o2[6], o2[7]);
#pragma unroll
            for (int hh = 0; hh < 4; ++hh) {
                bf16_t* d = ((bf16_t*)(p.ws + OFF_LK)) + (size_t)token * 384 + hh * 96 + 64 + hi * 8;
                *(u32x4*)d = w1; *(u32x4*)(d + 16) = w2;
            }
        }
    }
}

__device__ __forceinline__ void phase_small(const Params& p, int l, char* lds) {
    float* fl = (float*)lds;
    for (int task = blockIdx.x; task < 8 + 256; task += gridDim.x) {
        const int tid = otid(), lane = tid & 63, wid = __builtin_amdgcn_readfirstlane(tid >> 6);
        if (task < 8) {
            const int b = task >> 2, hd = task & 3;
            float v[16]; float run = 0.f;
#pragma unroll
            for (int i = 0; i < 16; ++i) { run += ((float*)(p.ws + OFF_LOGF))[((size_t)b * S_ + tid * 16 + i) * 4 + hd]; v[i] = run; }
            float sc = run;
#pragma unroll
            for (int o = 1; o < 64; o <<= 1) { const float t = __shfl_up(sc, o); if (lane >= o) sc += t; }
            if (lane == 63) fl[wid] = sc;
            __syncthreads();
            float woff = 0.f;
            for (int w = 0; w < wid; ++w) woff += fl[w];
            const float base = woff + sc - run;
#pragma unroll
            for (int i = 0; i < 16; ++i) ((float*)(p.ws + OFF_NEGC))[(size_t)task * S_ + tid * 16 + i] = -(base + v[i]) * LOG2E;
            __syncthreads();
        } else {
            mla_stage2(p, l, (task - 8) * 8 + wid);
        }
    }
}

template <int DQK, int MODE>
__device__ __forceinline__ void attn_core(const bf16_t* __restrict__ Qp, int qpitch, const bf16_t* __restrict__ Kp, int kpitch, const bf16_t* __restrict__ Vp, int vpitch,
                                          int qb, char* lds, f32x16 (&o)[2], const float* __restrict__ negc, const float* btab, unsigned sel, const float* __restrict__ norms = nullptr) {
    constexpr int NCH = DQK / 8, KRS = DQK * 2 + 16, KBUF = 64 * KRS, VBUF = 8192, BUFSZ = KBUF + VBUF + 256;
    const int tid = otid(), lane = tid & 63, r32 = lane & 31, hi = lane >> 5, wid = __builtin_amdgcn_readfirstlane(tid >> 6);
    const int q0w = qb * 256 + wid * 32, qrow = q0w + r32, NT = 4 * qb + 4;
    bf16x8 qf[DQK / 16];
#pragma unroll
    for (int d0 = 0; d0 < DQK / 16; ++d0) qf[d0] = *(const bf16x8*)(Qp + (size_t)qrow * qpitch + d0 * 16 + hi * 8);
#pragma unroll
    for (int r = 0; r < 16; ++r) { o[0][r] = 0.f; o[1][r] = 0.f; }
    float m = -1e30f, l = 0.f;
    const int kkey0 = tid / NCH, kc0 = tid % NCH;
    const int p1 = tid + 512, kkey1 = p1 / NCH, kc1 = p1 % NCH;
    const bool k0v = tid < 64 * NCH, k1v = p1 < 64 * NCH;
    const int vkey = tid >> 3, vc = tid & 7;
    const int vdst = (vc >> 2) * 4096 + vkey * 64 + (vc & 3) * 16;
    u32x4 rk0, rk1, rv; float rbias = 0.f;
    rk0 = (u32x4){0u, 0u, 0u, 0u}; rk1 = rk0;
#define ATT_LOAD(j) do { \
        if (k0v) rk0 = *(const u32x4*)(Kp + (size_t)((j) * 64 + kkey0) * kpitch + kc0 * 8); \
        if (k1v) rk1 = *(const u32x4*)(Kp + (size_t)((j) * 64 + kkey1) * kpitch + kc1 * 8); \
        rv = *(const u32x4*)(Vp + (size_t)((j) * 64 + vkey) * vpitch + vc * 8); \
        if (MODE == 1 && tid < 64) rbias = negc[(j) * 64 + tid]; } while (0)
#define ATT_STORE(bufi) do { char* bb = lds + (bufi) * BUFSZ; \
        if (k0v) *(u32x4*)(bb + kkey0 * KRS + kc0 * 16) = rk0; \
        if (k1v) *(u32x4*)(bb + kkey1 * KRS + kc1 * 16) = rk1; \
        *(u32x4*)(bb + KBUF + vdst) = rv; \
        if (MODE == 1 && tid < 64) *(float*)(bb + KBUF + VBUF + tid * 4) = rbias; } while (0)
    int j0 = 0;
    if (MODE == 1) {
        float qv = norms[lane & 31], kv = norms[256 + (lane & 31)];
#pragma unroll
        for (int o_ = 16; o_ >= 1; o_ >>= 1) { qv = fmaxf(qv, __shfl_xor(qv, o_)); kv = fmaxf(kv, __shfl_xor(kv, o_)); }
        const float qk2 = 2.0f * sqrtf(qv * kv) * 1.0001f + 1.0f;
        const float nq0 = negc[qb * 256];
        const int ja = lane, jb = lane + 64;
        const bool sa = (ja < NT - 4) && (negc[min(ja, NT - 1) * 64 + 63] - nq0 + qk2 < -160.f);
        const bool sb = (jb < NT - 4) && (negc[min(jb, NT - 1) * 64 + 63] - nq0 + qk2 < -160.f);
        const unsigned long long ba = __ballot(sa), bb = __ballot(sb);
        int cnt = (ba == ~0ull) ? 64 + (int)__builtin_ctzll(~bb | (1ull << 63)) : (int)__builtin_ctzll(~ba);
        if (bb == ~0ull && ba == ~0ull) cnt = 128;
        j0 = __builtin_amdgcn_readfirstlane(cnt);
    }
    ATT_LOAD(j0); ATT_STORE(j0 & 1);
    __syncthreads();
    const float c31 = (MODE >= 2) ? btab[127] : 0.f;
    float cref = c31;
    const int vlane = ((lane >> 4) & 1) * 32 + (lane & 3) * 8 + (4 * hi + ((lane & 15) >> 2)) * 64;
    for (int j = j0; j < NT; ++j) {
        const int buf = j & 1;
        if (j + 1 < NT) ATT_LOAD(j + 1);
        __builtin_amdgcn_sched_barrier(0);
        const int kbase = j * 64;
        bool active = kbase <= q0w + 31;
        bool selected = true;
        if (MODE == 3) { const int blk = j >> 2; if (blk < qb) { selected = (sel >> blk) & 1u; active = active && (__ballot(selected) != 0ull); } }
        if (active) {
            const char* kb = lds + buf * BUFSZ;
            f32x16 s0, s1;
            if (MODE == 1) {
                const float* nb = (const float*)(kb + KBUF + VBUF);
#pragma unroll
                for (int g = 0; g < 4; ++g) { const f32x4 t0 = *(const f32x4*)(nb + 8 * g + 4 * hi), t1 = *(const f32x4*)(nb + 32 + 8 * g + 4 * hi);
#pragma unroll
                    for (int i = 0; i < 4; ++i) { s0[4 * g + i] = t0[i]; s1[4 * g + i] = t1[i]; } }
#pragma unroll
                for (int d0 = 0; d0 < DQK / 16; ++d0) {
                    const bf16x8 kf0 = *(const bf16x8*)(kb + r32 * KRS + d0 * 32 + hi * 16), kf1 = *(const bf16x8*)(kb + (32 + r32) * KRS + d0 * 32 + hi * 16);
                    s0 = MFMA32(kf0, qf[d0], s0); s1 = MFMA32(kf1, qf[d0], s1);
                }
                if (kbase + 63 > q0w) {
#pragma unroll
                    for (int r = 0; r < 16; ++r) { const int key = kbase + crow(r, hi); if (key > qrow) s0[r] = -INFINITY; if (key + 32 > qrow) s1[r] = -INFINITY; }
                }
                float mx = fmaxf(s0[0], s1[0]);
#pragma unroll
                for (int r = 1; r < 16; ++r) mx = fmaxf(mx, fmaxf(s0[r], s1[r]));
                mx = swapmax(mx);
                const float mn = fmaxf(m, mx);
                if (__any(mn > m)) {
                    const float a = fexp2(m - mn);
                    l *= a;
#pragma unroll
                    for (int r = 0; r < 16; ++r) { o[0][r] *= a; o[1][r] *= a; }
                }
                m = mn;
                float ls = 0.f;
#pragma unroll
                for (int r = 0; r < 16; ++r) { s0[r] = fexp2(s0[r] - m); s1[r] = fexp2(s1[r] - m); ls += s0[r] + s1[r]; }
                l += ls;
            } else {
                f32x16 ci;
                {
                    const float cv = (MODE == 3 && !selected) ? -INFINITY : cref;
#pragma unroll
                    for (int r = 0; r < 16; ++r) ci[r] = cv;
                }
                {
                    const bf16x8 kf0 = *(const bf16x8*)(kb + r32 * KRS + hi * 16), kf1 = *(const bf16x8*)(kb + (32 + r32) * KRS + hi * 16);
                    s0 = MFMA32(kf0, qf[0], ci); s1 = MFMA32(kf1, qf[0], ci);
                }
#pragma unroll
                for (int d0 = 1; d0 < DQK / 16; ++d0) {
                    const bf16x8 kf0 = *(const bf16x8*)(kb + r32 * KRS + d0 * 32 + hi * 16), kf1 = *(const bf16x8*)(kb + (32 + r32) * KRS + d0 * 32 + hi * 16);
                    s0 = MFMA32(kf0, qf[d0], s0); s1 = MFMA32(kf1, qf[d0], s1);
                }
                if (MODE == 0) {
                    if (kbase + 63 > q0w) {
#pragma unroll
                        for (int r = 0; r < 16; ++r) { const int key = kbase + crow(r, hi); if (key > qrow) s0[r] = -INFINITY; if (key + 32 > qrow) s1[r] = -INFINITY; }
                    }
                } else {
                    if (!(q0w - (kbase + 63) >= 127)) {
#pragma unroll
                        for (int r = 0; r < 16; ++r) {
                            const int d0_ = qrow - (kbase + crow(r, hi)), d1_ = d0_ - 32;
                            const float b0 = btab[min(max(d0_, 0), 127)] - c31, b1 = btab[min(max(d1_, 0), 127)] - c31;
                            s0[r] = (d0_ < 0) ? -INFINITY : s0[r] + b0;
                            s1[r] = (d1_ < 0) ? -INFINITY : s1[r] + b1;
                        }
                    }
                }
                float mx = fmaxf(s0[0], s1[0]);
#pragma unroll
                for (int r = 1; r < 16; ++r) mx = fmaxf(mx, fmaxf(s0[r], s1[r]));
                mx = swapmax(mx);
                if (__any(mx > 8.0f)) {
                    const float dlt = fmaxf(mx, 0.f), a = fexp2(-dlt);
                    l *= a;
#pragma unroll
                    for (int r = 0; r < 16; ++r) { s0[r] -= dlt; s1[r] -= dlt; o[0][r] *= a; o[1][r] *= a; }
                    cref -= dlt;
                }
                float ls = 0.f;
#pragma unroll
                for (int r = 0; r < 16; ++r) { s0[r] = fexp2(s0[r]); s1[r] = fexp2(s1[r]); ls += s0[r] + s1[r]; }
                l += ls;
            }
            u32x4 pw[4];
            pw[0] = (u32x4){cvtpk(s0[0], s0[1]), cvtpk(s0[2], s0[3]), cvtpk(s0[4], s0[5]), cvtpk(s0[6], s0[7])};
            pw[1] = (u32x4){cvtpk(s0[8], s0[9]), cvtpk(s0[10], s0[11]), cvtpk(s0[12], s0[13]), cvtpk(s0[14], s0[15])};
            pw[2] = (u32x4){cvtpk(s1[0], s1[1]), cvtpk(s1[2], s1[3]), cvtpk(s1[4], s1[5]), cvtpk(s1[6], s1[7])};
            pw[3] = (u32x4){cvtpk(s1[8], s1[9]), cvtpk(s1[10], s1[11]), cvtpk(s1[12], s1[13]), cvtpk(s1[14], s1[15])};
            const LDSAS char* vb = (const LDSAS char*)(kb + KBUF) + vlane;
#pragma unroll
            for (int kk = 0; kk < 4; ++kk) {
                const bf16x8 pf = __builtin_bit_cast(bf16x8, pw[kk]);
#pragma unroll
                for (int dh = 0; dh < 2; ++dh) {
                    const s16x4 lo_ = vtr(vb + dh * 4096 + kk * 1024), hi_ = vtr(vb + dh * 4096 + kk * 1024 + 512);
                    const bf16x8 vf = (bf16x8){lo_[0], lo_[1], lo_[2], lo_[3], hi_[0], hi_[1], hi_[2], hi_[3]};
                    o[dh] = MFMA32(vf, pf, o[dh]);
                }
            }
        }
        if (j + 1 < NT) ATT_STORE(buf ^ 1);
        __syncthreads();
    }
#undef ATT_LOAD
#undef ATT_STORE
    l = swapsum(l);
    const float rl = 1.0f / l;
#pragma unroll
    for (int r = 0; r < 16; ++r) { o[0][r] *= rl; o[1][r] *= rl; }
}

__device__ __forceinline__ void store_o(bf16_t* dst  , const f32x16 (&o)[2], int hi) {
#pragma unroll
    for (int dh = 0; dh < 2; ++dh)
#pragma unroll
        for (int g = 0; g < 4; ++g) store4(dst + 32 * dh + 8 * g + 4 * hi, o[dh], g);
}

__device__ __forceinline__ void phase_attn(const Params& p, int l, char* lds, int coff = 0) {
    const int tid = otid(), lane = tid & 63, r32 = lane & 31, hi = lane >> 5, wid = __builtin_amdgcn_readfirstlane(tid >> 6);
    float* btab_all = (float*)(lds + 65536);
    int* s_unit = (int*)(lds + 65536 + 4096);
    for (int i = tid; i < 1024; i += 512) { const int hh = i >> 7, d = i & 127; btab_all[i] = p.rel_bias[((int*)(p.ws + OFF_BUCKET))[d] * 8 + hh] * LOG2E; }
    __syncthreads();
    float lam;
    {
        const float* dl = p.diff_lambda + l * 128;
        float s1 = 0.f, s2 = 0.f;
        for (int i = 0; i < 32; ++i) { s1 += dl[i] * dl[32 + i]; s2 += dl[64 + i] * dl[96 + i]; }
        lam = expf(s1) - expf(s2) + p.lam_init[l];
    }
    const float lam_init = p.lam_init[l];
    for (int qi = 0; qi < 8; ++qi) {
        const int xq = (blockIdx.x + qi) & 7;
        const int b = xq >> 2, hd = xq & 3;
        for (;;) {
            if (tid == 0) *s_unit = (int)atomicAdd(((unsigned*)(p.ws + OFF_COUNTERS)) + coff + l * 8 + xq, 1u);
            __syncthreads();
            const int u = __builtin_amdgcn_readfirstlane(*s_unit);
            __syncthreads();
            if (u >= 128) break;
            const int qb = u < 96 ? 31 - u / 3 : 127 - u, kind = u < 96 ? u % 3 : 3;
            const bf16_t* hb = ((bf16_t*)(p.ws + OFF_H)) + (size_t)b * S_ * NINP;
            const size_t orow = ((size_t)b * S_ + qb * 256 + wid * 32 + r32) * DM;
            f32x16 o[2];
            if (kind == 3) {
#ifndef SK3
                attn_core<64, 1>(hb + hd * 64, NINP, hb + 256 + hd * 64, NINP, hb + 512 + hd * 64, NINP, qb, lds, o, ((float*)(p.ws + OFF_NEGC)) + (size_t)xq * S_, nullptr, 0u, ((float*)(p.ws + OFF_NORMS)) + xq * 32);
                store_o(((bf16_t*)(p.ws + OFF_MIXB)) + orow + hd * 64, o, hi);
#endif
            } else if (kind == 1) {
#ifndef SK1
                attn_core<96, 0>(((bf16_t*)(p.ws + OFF_LQ)) + (size_t)b * S_ * 384 + hd * 96, 384, ((bf16_t*)(p.ws + OFF_LK)) + (size_t)b * S_ * 384 + hd * 96, 384, ((bf16_t*)(p.ws + OFF_LV)) + (size_t)b * S_ * 256 + hd * 64, 256, qb, lds, o, nullptr, nullptr, 0u);
                store_o(((bf16_t*)(p.ws + OFF_MIXB)) + orow + 768 + hd * 64, o, hi);
#endif
            } else if (kind == 2) {
#ifndef SK2
                unsigned sel = 0u;
                {
                    const bf16_t* Qp = hb + 1536 + hd * 64;
                    const int qrow = qb * 256 + wid * 32 + r32;
                    f32x16 gacc;
#pragma unroll
                    for (int r = 0; r < 16; ++r) gacc[r] = 0.f;
#pragma unroll
                    for (int d0 = 0; d0 < 4; ++d0) {
                        const bf16x8 qf = *(const bf16x8*)(Qp + (size_t)qrow * NINP + d0 * 16 + hi * 8);
                        const bf16x8 kh = *(const bf16x8*)(((bf16_t*)(p.ws + OFF_KMHI)) + ((size_t)xq * 32 + r32) * 64 + d0 * 16 + hi * 8);
                        const bf16x8 kl = *(const bf16x8*)(((bf16_t*)(p.ws + OFF_KMLO)) + ((size_t)xq * 32 + r32) * 64 + d0 * 16 + hi * 8);
                        gacc = MFMA32(kh, qf, gacc); gacc = MFMA32(kl, qf, gacc);
                    }
#pragma unroll
                    for (int r = 0; r < 16; ++r) if (crow(r, hi) >= qb) gacc[r] = -INFINITY;
#pragma unroll
                    for (int it = 0; it < 3; ++it) {
                        float bv = -INFINITY; int bi = 64;
#pragma unroll
                        for (int r = 0; r < 16; ++r) if (gacc[r] > bv) { bv = gacc[r]; bi = crow(r, hi); }
                        auto rv_ = __builtin_amdgcn_permlane32_swap(__float_as_uint(bv), __float_as_uint(bv), false, false);
                        auto ri_ = __builtin_amdgcn_permlane32_swap((unsigned)bi, (unsigned)bi, false, false);
                        const float v0 = __uint_as_float(rv_[0]), v1 = __uint_as_float(rv_[1]); const int i0 = (int)ri_[0], i1 = (int)ri_[1];
                        const bool first = (v0 > v1) || (v0 == v1 && i0 < i1);
                        const float wv = first ? v0 : v1; const int wi = first ? i0 : i1;
                        if (wv > -INFINITY) {
                            sel |= 1u << wi;
#pragma unroll
                            for (int r = 0; r < 16; ++r) if (crow(r, hi) == wi) gacc[r] = -INFINITY;
                        }
                    }
                }
                attn_core<64, 3>(hb + 1536 + hd * 64, NINP, hb + 1792 + hd * 64, NINP, hb + 2048 + hd * 64, NINP, qb, lds, o, nullptr, btab_all + (4 + hd) * 128, sel);
                store_o(((bf16_t*)(p.ws + OFF_MIXB)) + orow + 512 + hd * 64, o, hi);
#endif
            } else {
#ifndef SK0
                float* park = (float*)(lds + 73728) + tid;
                attn_core<32, 2>(hb + 768 + hd * 64, NINP, hb + 1024 + hd * 64, NINP, hb + 1280 + hd * 64, NINP, qb, lds, o, nullptr, btab_all + hd * 128, 0u);
#pragma unroll
                for (int dh = 0; dh < 2; ++dh)
#pragma unroll
                    for (int r = 0; r < 16; ++r) park[(dh * 16 + r) * 512] = o[dh][r];
                attn_core<32, 2>(hb + 768 + hd * 64 + 32, NINP, hb + 1024 + hd * 64 + 32, NINP, hb + 1280 + hd * 64, NINP, qb, lds, o, nullptr, btab_all + hd * 128, 0u);
                float ss = 0.f;
#pragma unroll
                for (int dh = 0; dh < 2; ++dh)
#pragma unroll
                    for (int r = 0; r < 16; ++r) { const float v = park[(dh * 16 + r) * 512] - lam * o[dh][r]; o[dh][r] = v; ss += v * v; }
                ss = swapsum(ss);
                const float rstd = rsqrtf(ss * (1.0f / 64.0f) + 1e-5f) * (1.0f - lam_init);
                const float* sg = p.diff_subln + l * 64; asm volatile("" : "+s"(sg));
#pragma unroll
                for (int dh = 0; dh < 2; ++dh)
#pragma unroll
                    for (int g = 0; g < 4; ++g) { const f32x4 gv = *(const f32x4*)(sg + 32 * dh + 8 * g + 4 * hi);
#pragma unroll
                        for (int i = 0; i < 4; ++i) o[dh][4 * g + i] *= rstd * gv[i]; }
                store_o(((bf16_t*)(p.ws + OFF_MIXB)) + orow + 256 + hd * 64, o, hi);
#endif
            }
        }
    }
    if (l < 3) {
        for (;;) {
            if (tid == 0) *s_unit = (int)atomicAdd(((unsigned*)(p.ws + OFF_COUNTERS)) + 48 + l, 1u);
            __syncthreads();
            const int r_ = __builtin_amdgcn_readfirstlane(*s_unit);
            __syncthreads();
            if (r_ >= 3112) break;
            convert_tile(p, l + 1, r_, lds);
        }
    }
}


#define XB_TMO      128
#define XB_XCNT(j)  (256  + 64 * (j))
#define XB_XSUB(j)  (1280 + 64 * (j))
#define XB_XGEN(j)  (2304 + 64 * (j))
#define XB_TOP      3328
#define XB_TOPGEN   3392
#define XCD_BAR_WORDS 3456
#define XB_SPIN_CAP (1u << 22)
__device__ __forceinline__ unsigned xb_ld(unsigned* p)              { return __hip_atomic_load(p, __ATOMIC_RELAXED, __HIP_MEMORY_SCOPE_AGENT); }
__device__ __forceinline__ unsigned xb_add(unsigned* p, unsigned v) { return __hip_atomic_fetch_add(p, v, __ATOMIC_RELAXED, __HIP_MEMORY_SCOPE_AGENT); }
__device__ __forceinline__ unsigned xb_xcc_id() { return (unsigned)__builtin_amdgcn_s_getreg((3 << 11) | 20) & 0xFu; }
#define XB_SPIN(cond, bar) do { unsigned _sp = 0; while (cond) { __builtin_amdgcn_s_sleep(1); \
    if ((++_sp & 255u) == 0u) { if (xb_ld(&(bar)[XB_TMO])) break; if (_sp > XB_SPIN_CAP) { atomicAdd(&(bar)[XB_TMO], 1u); break; } } } } while (0)
struct XcdBarrier { unsigned* bar; unsigned x; volatile LDSAS unsigned* st; };
__device__ __forceinline__ XcdBarrier xcd_barrier_post(unsigned* bar, volatile LDSAS unsigned* st) {
    XcdBarrier b; b.bar = bar; b.x = xb_xcc_id(); b.st = st;
    if (threadIdx.x == 0) (void)xb_add(&bar[XB_XCNT(b.x)], 1u);
    return b;
}
__device__ __forceinline__ void xcd_barrier_complete(unsigned* bar, unsigned x, unsigned& nloc, unsigned& nx) {
    const unsigned G = gridDim.x * gridDim.y * gridDim.z;
    unsigned sum, cnt, mine, sp = 0u;
    for (;;) {
        sum = 0u; cnt = 0u; mine = 0u;
#pragma unroll
        for (unsigned j = 0; j < 16; ++j) { const unsigned c = xb_ld(&bar[XB_XCNT(j)]); sum += c; cnt += (c > 0u) ? 1u : 0u; mine = (j == x) ? c : mine; }
        if (sum == G) break;
        __builtin_amdgcn_s_sleep(1);
        if ((++sp & 255u) == 0u) { if (xb_ld(&bar[XB_TMO])) break; if (sp > XB_SPIN_CAP) { atomicAdd(&bar[XB_TMO], 1u); break; } }
    }
    nloc = mine > 0u ? mine : 1u; nx = cnt > 0u ? cnt : 1u;
}
__device__ __forceinline__ void xcd_barrier(const XcdBarrier& b) {
    asm volatile("s_waitcnt vmcnt(0)" ::: "memory");
    __syncthreads();
    if (threadIdx.x == 0) {
        unsigned* bar = b.bar;
        __builtin_amdgcn_s_waitcnt(0);
        unsigned nloc = b.st[0], nx = b.st[1];
        if (nloc == 0u) { xcd_barrier_complete(bar, b.x, nloc, nx); b.st[0] = nloc; b.st[1] = nx; }
        const unsigned old = xb_add(&bar[XB_XSUB(b.x)], 1u);
        const unsigned gen = old / nloc;
        if (old + 1u == (gen + 1u) * nloc) {
            __builtin_amdgcn_fence(__ATOMIC_RELEASE, "agent");
            asm volatile("s_waitcnt vmcnt(0)" ::: "memory");
            const unsigned og = xb_add(&bar[XB_TOP], 1u);
            const unsigned tg = og / nx;
            if (og + 1u == (tg + 1u) * nx) xb_add(&bar[XB_TOPGEN], 1u);
            else XB_SPIN(xb_ld(&bar[XB_TOPGEN]) == tg, bar);
            __builtin_amdgcn_fence(__ATOMIC_ACQUIRE, "agent");
            xb_add(&bar[XB_XGEN(b.x)], 1u);
            asm volatile("s_waitcnt vmcnt(0)" ::: "memory");
        } else {
            XB_SPIN(xb_ld(&bar[XB_XGEN(b.x)]) == gen, bar);
            __builtin_amdgcn_fence(__ATOMIC_ACQUIRE, "agent");
            asm volatile("s_waitcnt vmcnt(0)" ::: "memory");
        }
    }
    __syncthreads();
}

#ifdef REP_SYNC
#define SYNC_IF(ph) if ((ph) + 1 < p.ph_end) { xcd_barrier(xb); xcd_barrier(xb); }
#else
#define SYNC_IF(ph) if ((ph) + 1 < p.ph_end) { xcd_barrier(xb); }
#endif
#define RUNPH(ph, stmt) if (p.ph_begin <= (ph) && (ph) < p.ph_end) { stmt; SYNC_IF(ph) }
template <int L>
__device__ __forceinline__ void run_layer(const Params& p, char* lds, cg::grid_group& grid, const XcdBarrier& xb) {
#ifdef REP_INPROJ
    RUNPH(1 + 8 * L + 0, ({ phase_inproj(p, L, lds); xcd_barrier(xb); phase_inproj(p, L, lds); }))
#else
    RUNPH(1 + 8 * L + 0, phase_inproj(p, L, lds))
#endif
#ifdef REP_SMALL
    RUNPH(1 + 8 * L + 1, ({ phase_small(p, L, lds); xcd_barrier(xb); phase_small(p, L, lds); }))
#else
    RUNPH(1 + 8 * L + 1, phase_small(p, L, lds))
#endif
#ifdef REP_ATTN
    RUNPH(1 + 8 * L + 2, ({ phase_attn(p, L, lds, 32); xcd_barrier(xb); phase_attn(p, L, lds); }))
#else
    RUNPH(1 + 8 * L + 2, phase_attn(p, L, lds))
#endif
    RUNPH(1 + 8 * L + 3, phase_resgemm(p, ((bf16_t*)(p.ws + OFF_MIXB)), DM, ((bf16_t*)(p.ws + OFF_WT_O)) + (size_t)L * DM * DM, DM, lds, L ? p.ln2_g + (L - 1) * DM : nullptr, L ? p.ln2_b + (L - 1) * DM : nullptr, L ? (const float*)p.out : p.x))
    RUNPH(1 + 8 * L + 4, phase_ln<false>(p, p.ln1_g + L * DM, p.ln1_b + L * DM))
#ifndef SKIP_UP
#ifdef REP_UP
    RUNPH(1 + 8 * L + 5, ({ phase_up(p, L, lds); xcd_barrier(xb); phase_up(p, L, lds); }))
#else
    RUNPH(1 + 8 * L + 5, phase_up(p, L, lds))
#endif
#else
    RUNPH(1 + 8 * L + 5, (void)0)
#endif
#ifdef DUMP_ACT
    RUNPH(1 + 8 * L + 6, ({ const int tid_ = otid();
        for (int i = blockIdx.x * 512 + tid_; i < T_ * DM; i += gridDim.x * 512) { const int tok = i >> 10, c = i & 1023;
            const float v_ = bf2f(((bf16_t*)(p.ws + DUMP_OFF))[(size_t)tok * DUMP_PITCH + c]); p.out[i] = (fabsf(v_) <= 3.0e38f) ? 0.f : 1000.f; } }))
#else
    RUNPH(1 + 8 * L + 6, phase_resgemm(p, ((bf16_t*)(p.ws + OFF_H)), DFFP, ((bf16_t*)(p.ws + OFF_WT_DN)) + (size_t)L * DM * DFFP, DFFP, lds, p.ln1_g + L * DM, p.ln1_b + L * DM, (const float*)p.out))
#endif
    RUNPH(1 + 8 * L + 7, phase_ln<(L == 3)>(p, p.ln2_g + L * DM, p.ln2_b + L * DM))
}

__global__ void __launch_bounds__(512) mega(Params p) {
    extern __shared__ __attribute__((aligned(16))) char lds[];
    cg::grid_group grid = cg::this_grid();
    volatile LDSAS unsigned* st_ = (volatile LDSAS unsigned*)(lds + 147456);
    if (threadIdx.x == 0) { st_[0] = 0u; st_[1] = 0u; }
    __syncthreads();
    const XcdBarrier xb = xcd_barrier_post((unsigned*)(p.ws + OFF_BAR), st_);
    grid.sync();
#ifdef REP_PRO
    RUNPH(0, ({ phase_prologue(p, lds); xcd_barrier(xb); phase_prologue(p, lds); }))
#else
    RUNPH(0, phase_prologue(p, lds))
#endif
    run_layer<0>(p, lds, grid, xb);
    run_layer<1>(p, lds, grid, xb);
    run_layer<2>(p, lds, grid, xb);
    run_layer<3>(p, lds, grid, xb);
}

extern "C" void kernel_launch(void* const* d_in, const int* in_sizes, int n_in, void* d_out, int out_size, void* d_ws, size_t ws_size, hipStream_t stream) {
    static int grid_blocks = 0;
    if (!grid_blocks) {
        int dev = 0, cus = 0, per_cu = 0;
        hipGetDevice(&dev);
        hipFuncSetAttribute((const void*)mega, hipFuncAttributeMaxDynamicSharedMemorySize, LDS_BYTES);
        hipDeviceGetAttribute(&cus, hipDeviceAttributeMultiprocessorCount, dev);
        hipOccupancyMaxActiveBlocksPerMultiprocessor(&per_cu, mega, 512, LDS_BYTES);
        if (per_cu < 1) per_cu = 1;
        grid_blocks = cus * 1;
        if (grid_blocks > 256) grid_blocks = 256;
        grid_blocks &= ~7;
    }
    Params p{};
    const float* const* in = (const float* const*)d_in;
    p.x = in[0]; p.w_in = in[1]; p.b_forget = in[2]; p.diff_lambda = in[3]; p.diff_subln = in[4]; p.mla_q_norm = in[5]; p.mla_kv_norm = in[6];
    p.mla_w_uq = in[7]; p.mla_w_ukv = in[8]; p.rel_bias = in[9]; p.w_o = in[10]; p.ln1_g = in[11]; p.ln1_b = in[12]; p.w_up = in[13];
    p.conv_w = in[14]; p.conv_b = in[15]; p.w_down = in[16]; p.ln2_g = in[17]; p.ln2_b = in[18];
    p.out = (float*)d_out;
    p.ws = (char*)d_ws; const size_t off = WS_NEEDED;
    hipMemsetAsync((char*)d_ws + OFF_BAR, 0, XCD_BAR_WORDS * 4, stream);
    for (int l = 0; l < 4; ++l) p.lam_init[l] = (float)(0.8 - 0.6 * exp(-0.3 * (double)l));
    if (off > ws_size) fprintf(stderr, "workspace too small: need %zu have %zu\n", off, ws_size);
#if N_LAUNCH_SPLIT
    for (int ph = 0; ph < 33; ++ph) {
        p.ph_begin = ph; p.ph_end = ph + 1;
        void* args[] = {&p};
        hipError_t e = hipLaunchCooperativeKernel((void*)mega, dim3(grid_blocks), dim3(512), args, LDS_BYTES, stream);
        if (e != hipSuccess) fprintf(stderr, "launch failed: %s\n", hipGetErrorString(e));
    }
#else
#ifndef PH_END
#define PH_END 33
#endif
    p.ph_begin = 0; p.ph_end = PH_END;
    void* args[] = {&p};
    hipError_t e = hipLaunchCooperativeKernel((void*)mega, dim3(grid_blocks), dim3(512), args, LDS_BYTES, stream);
    if (e != hipSuccess) fprintf(stderr, "cooperative launch failed: %s (grid %d)\n", hipGetErrorString(e), grid_blocks);
#endif
}
```
